# Optimizing an MI355X kernel written in HIP

```python
import jax, jax.numpy as jnp
from jax import lax
import numpy as np

D_MODEL = 1024
BATCH = 16
SEQ = 2048
DEPTH = 1

D_MIX = 2 * D_MODEL
A_HEADS = 16
A_HEAD_DIM = 64
A_WIDTH = A_HEADS * A_HEAD_DIM
A_ROT_DIM = A_HEAD_DIM // 4
DILATED_PATTERNS = ((128, 1), (512, 4), (2048, 16))
MLA_HEADS = 8
MLA_Q_RANK = 256
MLA_KV_RANK = 128
MLA_NOPE_DIM = 64
MLA_ROPE_DIM = 32
MLA_V_DIM = 64
MLA_WIDTH = MLA_HEADS * MLA_V_DIM
N_MEM = 256
MEM_HEADS = 4
MEM_HEAD_DIM = 128
MEM_WIDTH = MEM_HEADS * MEM_HEAD_DIM

ROPE_THETA = 500000.0
Q_BLOCK = 128
NORM_EPS = 1e-5
NEG_INF = -1e30
DEEPNORM_ALPHA = (2 * DEPTH) ** 0.25
DEEPNORM_BETA = (8 * DEPTH) ** -0.25

IN_SPLITS = (A_WIDTH, A_WIDTH, A_WIDTH, A_WIDTH,
             MLA_Q_RANK, MLA_KV_RANK, MLA_ROPE_DIM, MLA_WIDTH,
             MEM_WIDTH, MEM_WIDTH)
D_IN = sum(IN_SPLITS)

kernel_name = "hymba_dilated_mla_memory_deepnorm"


def _layer_norm(x, g, b):
    xf = x.astype(jnp.float32)
    mu = jnp.mean(xf, axis=-1, keepdims=True)
    var = jnp.mean(jnp.square(xf - mu), axis=-1, keepdims=True)
    return ((xf - mu) * lax.rsqrt(var + NORM_EPS) * g.astype(jnp.float32) + b.astype(jnp.float32)).astype(x.dtype)


def _rms_norm(x, g, out_dtype):
    xf = x.astype(jnp.float32)
    ms = jnp.mean(jnp.square(xf), axis=-1, keepdims=True)
    return (xf * lax.rsqrt(ms + NORM_EPS) * g.astype(jnp.float32)).astype(out_dtype)


def _rope(x, pos):
    r = x.shape[-1]
    inv_freq = ROPE_THETA ** (-(jnp.arange(0, r, 2, dtype=jnp.float32) / r))
    ang = pos.astype(jnp.float32)[..., None] * inv_freq
    cos, sin = jnp.cos(ang)[:, :, None, :], jnp.sin(ang)[:, :, None, :]
    xf = x.astype(jnp.float32)
    x1, x2 = xf[..., : r // 2], xf[..., r // 2:]
    return jnp.concatenate([x1 * cos - x2 * sin, x2 * cos + x1 * sin], axis=-1).astype(x.dtype)


def _partial_rope(x, pos):
    return jnp.concatenate([_rope(x[..., :A_ROT_DIM], pos), x[..., A_ROT_DIM:]], axis=-1)


def _window_attn(q, k, v, n_side):
    n, length, h, e = q.shape
    blk = n_side
    nb = -(-length // blk)
    pad = nb * blk - length
    qb = jnp.pad(q, ((0, 0), (0, pad), (0, 0), (0, 0))).reshape(n, nb, blk, h, e).astype(jnp.float32)

    def bands(t):
        tb = jnp.pad(t, ((0, 0), (blk, pad + blk), (0, 0), (0, 0))).reshape(n, nb + 2, blk, h, t.shape[-1])
        return jnp.concatenate([tb[:, :-2], tb[:, 1:-1], tb[:, 2:]], axis=2).astype(jnp.float32)

    kb, vb = bands(k), bands(v)
    qpos = jnp.arange(nb)[:, None] * blk + jnp.arange(blk)[None, :]
    kpos = (jnp.arange(nb)[:, None] - 1) * blk + jnp.arange(3 * blk)[None, :]
    off = kpos[:, None, :] - qpos[:, :, None]
    valid = (jnp.abs(off) <= n_side) & (kpos[:, None, :] >= 0) & (kpos[:, None, :] < length)
    s = jnp.einsum('nbqhe,nbkhe->nbhqk', qb, kb) * (e ** -0.5)
    s = jnp.where(valid[None, :, None], s, NEG_INF)
    m = jnp.max(s, axis=-1, keepdims=True)
    p = jnp.exp(s - m)
    den = jnp.sum(p, axis=-1, keepdims=True)
    o = jnp.einsum('nbhqk,nbkhe->nbqhe', p / den, vb).reshape(n, nb * blk, h, vb.shape[-1])[:, :length]
    lse = (m + jnp.log(den))[..., 0]
    lse = lse.transpose(0, 1, 3, 2).reshape(n, nb * blk, h)[:, :length]
    return o, lse


def _dilated_attention(q, k, v):
    b, s, h, e = q.shape
    outs, lses = [], []
    for window, dil in DILATED_PATTERNS:
        n_side = window // (2 * dil)
        length = s // dil

        def to_sub(t):
            return t.reshape(b, length, dil, h, t.shape[-1]).transpose(0, 2, 1, 3, 4).reshape(b * dil, length, h, t.shape[-1])

        o, lse = _window_attn(to_sub(q), to_sub(k), to_sub(v), n_side)
        outs.append(o.reshape(b, dil, length, h, e).transpose(0, 2, 1, 3, 4).reshape(b, s, h, e))
        lses.append(lse.reshape(b, dil, length, h).transpose(0, 2, 1, 3).reshape(b, s, h))
    w = jax.nn.softmax(jnp.stack(lses, axis=0), axis=0)
    return jnp.einsum('gbsh,gbshe->bshe', w, jnp.stack(outs, axis=0))


def _mla_attention(q_nope, q_rope, k_nope, k_rope, v):
    b, s, h, _ = q_nope.shape
    scale = (MLA_NOPE_DIM + MLA_ROPE_DIM) ** -0.5
    nq = s // Q_BLOCK
    kn, kr, vf = k_nope.astype(jnp.float32), k_rope.astype(jnp.float32), v.astype(jnp.float32)

    def blocks(t):
        return t.reshape((b, nq, Q_BLOCK) + t.shape[2:]).swapaxes(0, 1)

    def one_block(args):
        qn, qr = args
        sc = (jnp.einsum('bqhe,bkhe->bhqk', qn.astype(jnp.float32), kn)
              + jnp.einsum('bqhr,bkr->bhqk', qr.astype(jnp.float32), kr)) * scale
        p = jax.nn.softmax(sc, axis=-1)
        return jnp.einsum('bhqk,bkhe->bqhe', p, vf)

    o = lax.map(one_block, (blocks(q_nope), blocks(q_rope)))
    return o.swapaxes(0, 1).reshape(b, s, h, v.shape[-1])


def _memory_attention(q, k, v):
    sc = jnp.einsum('bshe,bmhe->bhsm', q.astype(jnp.float32), k.astype(jnp.float32)) * (q.shape[-1] ** -0.5)
    p = jax.nn.softmax(sc, axis=-1)
    return jnp.einsum('bhsm,bmhe->bshe', p, v.astype(jnp.float32))


def _hybrid_layer(h, pos, mem, w_in, g_cq, g_ckv, w_uq, w_ukv, w_mem_kv,
                  g_out_a, g_out_b, g_out_m, w_out, g_post, b_post):
    b, s, _ = h.shape
    dt = h.dtype
    idx = [int(i) for i in np.cumsum(IN_SPLITS)[:-1]]
    proj = h @ w_in
    a_q, a_k, a_v, a_g, c_q, c_kv, b_kr, b_g, m_q, m_g = jnp.split(proj, idx, axis=-1)

    hd = (b, s, A_HEADS, A_HEAD_DIM)
    y_a = _dilated_attention(_partial_rope(a_q.reshape(hd), pos),
                             _partial_rope(a_k.reshape(hd), pos),
                             a_v.reshape(hd)).reshape(b, s, A_WIDTH)

    q = (_rms_norm(c_q, g_cq, dt) @ w_uq).reshape(b, s, MLA_HEADS, MLA_NOPE_DIM + MLA_ROPE_DIM)
    q_nope, q_rope = q[..., :MLA_NOPE_DIM], _rope(q[..., MLA_NOPE_DIM:], pos)
    kv = (_rms_norm(c_kv, g_ckv, dt) @ w_ukv).reshape(b, s, MLA_HEADS, MLA_NOPE_DIM + MLA_V_DIM)
    k_nope, v = kv[..., :MLA_NOPE_DIM], kv[..., MLA_NOPE_DIM:]
    k_rope = _rope(b_kr[:, :, None, :], pos)[:, :, 0]
    y_b = _mla_attention(q_nope, q_rope, k_nope, k_rope, v).reshape(b, s, MLA_WIDTH)

    mkv = mem @ w_mem_kv
    mk = mkv[..., :MEM_WIDTH].reshape(b, -1, MEM_HEADS, MEM_HEAD_DIM)
    mv = mkv[..., MEM_WIDTH:].reshape(b, -1, MEM_HEADS, MEM_HEAD_DIM)
    y_m = _memory_attention(m_q.reshape(b, s, MEM_HEADS, MEM_HEAD_DIM), mk, mv).reshape(b, s, MEM_WIDTH)

    y = jnp.concatenate([_rms_norm(y_a, g_out_a, dt) * jax.nn.silu(a_g),
                         _rms_norm(y_b, g_out_b, dt) * jax.nn.silu(b_g),
                         _rms_norm(y_m, g_out_m, dt) * jax.nn.silu(m_g)], axis=-1)
    sub = y @ w_out
    return _layer_norm(DEEPNORM_ALPHA * h + sub, g_post, b_post)


def setup_inputs(seed: int = 0) -> dict:
    key = jax.random.key(seed)
    ks = jax.random.split(key, 20)
    f32 = jnp.float32

    def nrm(k, shape, fan_in, scale=1.0):
        return jax.random.normal(k, shape, f32) * (fan_in ** -0.5) * scale

    def gain(k, shape):
        return 1.0 + 0.02 * jax.random.normal(k, shape, f32)

    x = jax.random.normal(ks[0], (BATCH, SEQ, D_MODEL), f32)
    mem = jax.random.normal(ks[1], (BATCH, N_MEM, D_MODEL), f32)
    offsets = jax.random.randint(ks[2], (BATCH, 1), 0, 4096, dtype=jnp.int32)
    positions = offsets + jnp.arange(SEQ, dtype=jnp.int32)[None, :]
    return {
        "x": x,
        "mem": mem,
        "positions": positions,
        "g_emb": gain(ks[3], (D_MODEL,)),
        "b_emb": 0.02 * jax.random.normal(ks[4], (D_MODEL,), f32),
        "w_in": nrm(ks[5], (DEPTH, D_MODEL, D_IN), D_MODEL),
        "g_cq": gain(ks[6], (DEPTH, MLA_Q_RANK)),
        "g_ckv": gain(ks[7], (DEPTH, MLA_KV_RANK)),
        "w_uq": nrm(ks[8], (DEPTH, MLA_Q_RANK, MLA_HEADS * (MLA_NOPE_DIM + MLA_ROPE_DIM)), MLA_Q_RANK),
        "w_ukv": nrm(ks[9], (DEPTH, MLA_KV_RANK, MLA_HEADS * (MLA_NOPE_DIM + MLA_V_DIM)), MLA_KV_RANK),
        "w_mem_kv": nrm(ks[10], (DEPTH, D_MODEL, 2 * MEM_WIDTH), D_MODEL),
        "g_out_a": gain(ks[11], (DEPTH, A_WIDTH)),
        "g_out_b": gain(ks[12], (DEPTH, MLA_WIDTH)),
        "g_out_m": gain(ks[13], (DEPTH, MEM_WIDTH)),
        "w_out": nrm(ks[14], (DEPTH, D_MIX, D_MODEL), D_MIX, DEEPNORM_BETA),
        "g_post": gain(ks[15], (DEPTH, D_MODEL)),
        "b_post": 0.02 * jax.random.normal(ks[16], (DEPTH, D_MODEL), f32),
    }


def reference(x, mem, positions, g_emb, b_emb, w_in, g_cq, g_ckv, w_uq, w_ukv, w_mem_kv,
              g_out_a, g_out_b, g_out_m, w_out, g_post, b_post):
    h = _layer_norm(x, g_emb, b_emb)
    for l in range(DEPTH):
        h = _hybrid_layer(h, positions, mem, w_in[l], g_cq[l], g_ckv[l], w_uq[l], w_ukv[l], w_mem_kv[l],
                          g_out_a[l], g_out_b[l], g_out_m[l], w_out[l], g_post[l], b_post[l])
    return h
```

```cpp
#include <hip/hip_runtime.h>
#include <hip/hip_cooperative_groups.h>
#include <cstdio>
#include <cstdint>
namespace cg = cooperative_groups;

#define LAS __attribute__((address_space(3)))
#define DI __device__ __forceinline__
typedef unsigned short bf16_t;
typedef short bf16x8 __attribute__((ext_vector_type(8)));
typedef short s16x4 __attribute__((ext_vector_type(4)));
typedef float f32x4 __attribute__((ext_vector_type(4)));
typedef float f32x2 __attribute__((ext_vector_type(2)));
typedef float f32x16 __attribute__((ext_vector_type(16)));
typedef unsigned u32x4 __attribute__((ext_vector_type(4)));
typedef unsigned u32x2 __attribute__((ext_vector_type(2)));
typedef __bf16 bf16x2_t __attribute__((ext_vector_type(2)));

constexpr int BATCH = 16, SEQ = 2048, DM = 1024, T = BATCH * SEQ, NMEM = 256;
constexpr int NP = 6144;
constexpr int C_AQ = 0, C_AK = 1024, C_AV = 2048, C_AG = 3072, C_BG = 4096, C_MG = 4608, C_MQ = 5120, C_CQ = 5632, C_CKV = 5888, C_KR = 6016;
constexpr float EPS = 1e-5f;
constexpr float LOG2E = 1.4426950408889634f;
constexpr float ALPHA = 1.189207115002721f;
constexpr float NEGBIG = -1e30f;

constexpr size_t MiB = 1u << 20;
constexpr size_t WS_PROJ = 0, WS_KVB = 384 * MiB, WS_WIN = 448 * MiB, WS_WOUT = 460 * MiB, WS_WMEM = 464 * MiB, WS_WUQ = 466 * MiB, WS_WUKV = 467 * MiB,
                 WS_MEMB = 468 * MiB, WS_MKV = 476 * MiB, WS_ROPEA = 484 * MiB, WS_ROPEB = 486 * MiB, WS_XSTAT = 490 * MiB, WS_SSQQ = 491 * MiB, WS_SSQKV = 492 * MiB,
                 WS_SSQY = 493 * MiB, WS_PSTAT = 497 * MiB, WS_BAR = 501 * MiB, WS_END = 502 * MiB;
constexpr size_t OUT_H = 0, OUT_QB = 64 * MiB;

constexpr int LDS_BYTES = 155648;
constexpr int NTHREADS = 512;

DI unsigned cvtpk(float lo, float hi) { f32x2 v = {lo, hi}; bf16x2_t b = __builtin_convertvector(v, bf16x2_t); return __builtin_bit_cast(unsigned, b); }
DI float bf2f(unsigned short u) { return __builtin_bit_cast(float, (unsigned)u << 16); }
DI float wave_sum(float v) {
#pragma unroll
    for (int o = 1; o < 64; o <<= 1) v += __shfl_xor(v, o);
    return v;
}
DI float fast_exp2(float x) { return __builtin_amdgcn_exp2f(x); }
DI float silu(float g) { return g * __builtin_amdgcn_rcpf(1.0f + fast_exp2(-g * LOG2E)); }

namespace pg8 {
constexpr int BM = 256, BK = 64, HALF = 128, HTB = HALF * BK * 2, STAGE_BYTES = 8 * HTB, NXCD = 8, WGM = 8;
__host__ __device__ __forceinline__ int lds_byte(int r, int c) { const int st = (r >> 4) * 2 + (c >> 5), rr = r & 15, cc = c & 31, ob = rr * 64 + cc * 2; return st * 1024 + (ob ^ (((ob >> 9) & 1) << 5)); }
__host__ __device__ __forceinline__ void stage_rc(int b, int& R, int& C) { const int st = b / 1024, sb = b % 1024, swz = sb ^ (((sb >> 9) & 1) << 5); R = (st >> 1) * 16 + swz / 64; C = (st & 1) * 32 + (swz % 64) / 2; }
__host__ __device__ __forceinline__ int perm32(int rho) { const int n = rho >> 4, i = rho & 15; return 8 * (i >> 2) + 4 * n + (i & 3); }

struct Unit { int pm, pn; };
struct Gemm { const bf16_t* A; const bf16_t* Bt; int lda, ldb, K; };

struct StaticOrder {
    int nM, nN, nwg, G, c;
    __device__ void init(int M, int N, int G_, int c_) { nM = M / BM; nN = N / BM; nwg = nM * nN; G = G_; c = c_; }
    __device__ bool next(int i, Unit& u) const {
        const long L = (long)i * G + c; if (L >= nwg) return false;
        int wgid = (int)L; { const int q = nwg / NXCD, r = nwg % NXCD, xcd = wgid % NXCD, off = wgid / NXCD; wgid = (xcd < r ? xcd * (q + 1) : r * (q + 1) + (xcd - r) * q) + off; }
        const int nig = WGM * nN, gid = wgid / nig, fm = gid * WGM, gsz = (nM - fm) < WGM ? (nM - fm) : WGM;
        u.pm = fm + ((wgid % nig) % gsz); u.pn = (wgid % nig) / gsz; return true;
    }
};

template <class Epi, bool HOOK>
DI void gemm_phase(LAS unsigned char* lds, const Gemm g, const StaticOrder& S, const Epi& E) {
    int tid_ = threadIdx.x; asm volatile("" : "+v"(tid_));
    const int tid = tid_, wid = __builtin_amdgcn_readfirstlane(tid >> 6), lane = tid & 63, wr = wid >> 2, wc = wid & 3, fr = lane & 15, fq = lane >> 4;
    const int K = g.K, nt = K / BK;
    unsigned voffA[2], voffB[2];
#pragma unroll
    for (int i = 0; i < 2; ++i) { int R, C; stage_rc(tid * 16 + i * 8192, R, C); const int Rb = (R & ~31) + perm32(R & 31);
        voffA[i] = (unsigned)(R * g.lda + C) * 2u; voffB[i] = (unsigned)(Rb * g.ldb + C) * 2u; }
    const size_t kstep = (size_t)(BK * 2);
    const size_t hstepA = (size_t)HALF * g.lda * 2, hstepB = (size_t)HALF * g.ldb * 2;
    const size_t tstepA = 2 * hstepA, tstepB = 2 * hstepB;
    const unsigned ldsw = (unsigned)wid * 1024u;
    const int aoff = lds_byte(wr * 64 + fr, fq * 8), boff = lds_byte(wc * 32 + fr, fq * 8);
#define PG8_SA(b, h) (((b) * 2 + (h)) * HTB)
#define PG8_SB(b, h) ((4 + (b) * 2 + (h)) * HTB)
#define PG8_STAGE(bufoff, gbase, voff) do { _Pragma("unroll") for (int _i = 0; _i < 2; ++_i) \
        __builtin_amdgcn_global_load_lds((const unsigned*)((const char*)(gbase) + (voff)[_i]), (LAS unsigned*)(lds + (bufoff) + ldsw + _i * 8192), 16, 0, 0); } while (0)
#define PG8_LDA(dst, b, h) do { _Pragma("unroll") for (int m = 0; m < 4; ++m) _Pragma("unroll") for (int k = 0; k < 2; ++k) dst[m][k] = *(const LAS bf16x8*)(lds + PG8_SA(b, h) + aoff + m * 2048 + k * 1024); } while (0)
#define PG8_LDB(dst, b, h) do { _Pragma("unroll") for (int n = 0; n < 2; ++n) _Pragma("unroll") for (int k = 0; k < 2; ++k) dst[n][k] = *(const LAS bf16x8*)(lds + PG8_SB(b, h) + boff + n * 2048 + k * 1024); } while (0)
#define PG8_MMA(ai, bj, At, Bt) do { __builtin_amdgcn_s_setprio(1); _Pragma("unroll") for (int m = 0; m < 4; ++m) _Pragma("unroll") for (int n = 0; n < 2; ++n) _Pragma("unroll") for (int k = 0; k < 2; ++k) \
        acc[ai][bj][m][n] = __builtin_amdgcn_mfma_f32_16x16x32_bf16(Bt[n][k], At[m][k], acc[ai][bj][m][n], 0, 0, 0); __builtin_amdgcn_s_setprio(0); } while (0)
#define PG8_WAIT_V(n) asm volatile("s_waitcnt vmcnt(" #n ")" ::: "memory")
#define PG8_WAIT_L(n) asm volatile("s_waitcnt lgkmcnt(" #n ")" ::: "memory")
#define PG8_BAR __builtin_amdgcn_s_barrier()
#define PG8_SCHED __builtin_amdgcn_sched_barrier(0)
    Unit cur, nxt; int ui = 0;
    if (!S.next(0, cur)) return;
    f32x4 acc[2][2][4][2];
#pragma unroll
    for (int a = 0; a < 2; ++a)
#pragma unroll
        for (int b = 0; b < 2; ++b)
#pragma unroll
            for (int m = 0; m < 4; ++m)
#pragma unroll
                for (int n = 0; n < 2; ++n) acc[a][b][m][n] = (f32x4){0.f, 0.f, 0.f, 0.f};
    bf16x8 At[4][2], B0[2][2], B1[2][2];
    const char* cA = (const char*)g.A + (size_t)cur.pm * tstepA; const char* cB = (const char*)g.Bt + (size_t)cur.pn * tstepB;
    PG8_STAGE(PG8_SB(0, 0), cB, voffB); PG8_STAGE(PG8_SB(0, 1), cB + hstepB, voffB); PG8_STAGE(PG8_SA(0, 0), cA, voffA); PG8_STAGE(PG8_SA(0, 1), cA + hstepA, voffA);
    if (wr == 1) PG8_BAR;
    PG8_WAIT_V(2); PG8_BAR;
    PG8_STAGE(PG8_SB(1, 0), cB + kstep, voffB); PG8_STAGE(PG8_SA(1, 0), cA + kstep, voffA); PG8_STAGE(PG8_SB(1, 1), cB + hstepB + kstep, voffB);
    PG8_WAIT_V(6); PG8_BAR;
    for (;;) {
        const bool has_next = S.next(ui + 1, nxt);
        const char* nA = has_next ? (const char*)g.A + (size_t)nxt.pm * tstepA : cA; const char* nB = has_next ? (const char*)g.Bt + (size_t)nxt.pn * tstepB : cB;
#pragma unroll 1
        for (int t = 0; t < nt; t += 2) {
            const bool last = (t == nt - 2);
            const char* a1 = cA + (size_t)(t + 1) * kstep;
            const char* a2 = last ? nA : cA + (size_t)(t + 2) * kstep; const char* b2 = last ? nB : cB + (size_t)(t + 2) * kstep;
            const char* a3 = a2 + kstep; const char* b3 = b2 + kstep;
            if constexpr (HOOK) { if (t == 16 || t == 24) E.hook(acc, ui, t, wr, fr); }
            PG8_LDB(B0, 0, 0); PG8_LDB(B1, 0, 1); PG8_SCHED; PG8_LDA(At, 0, 0); PG8_STAGE(PG8_SA(1, 1), a1 + hstepA, voffA);
            PG8_WAIT_V(8); PG8_WAIT_L(0); PG8_BAR; PG8_MMA(0, 0, At, B0); PG8_MMA(0, 1, At, B1); PG8_BAR; PG8_SCHED;
            PG8_LDA(At, 0, 1); PG8_STAGE(PG8_SB(0, 0), b2, voffB); PG8_STAGE(PG8_SB(0, 1), b2 + hstepB, voffB); PG8_STAGE(PG8_SA(0, 0), a2, voffA);
            PG8_WAIT_V(8); PG8_WAIT_L(0); PG8_BAR; PG8_MMA(1, 0, At, B0); PG8_MMA(1, 1, At, B1); PG8_BAR; PG8_SCHED;
            PG8_LDB(B0, 1, 0); PG8_LDB(B1, 1, 1); PG8_SCHED; PG8_LDA(At, 1, 0); PG8_STAGE(PG8_SA(0, 1), a2 + hstepA, voffA);
            PG8_WAIT_V(8); PG8_WAIT_L(0); PG8_BAR; PG8_MMA(0, 0, At, B0); PG8_MMA(0, 1, At, B1); PG8_BAR; PG8_SCHED;
            PG8_LDA(At, 1, 1); PG8_STAGE(PG8_SB(1, 0), b3, voffB); PG8_STAGE(PG8_SB(1, 1), b3 + hstepB, voffB); PG8_STAGE(PG8_SA(1, 0), a3, voffA);
            PG8_WAIT_V(8); PG8_WAIT_L(0); PG8_BAR; PG8_MMA(1, 0, At, B0); PG8_MMA(1, 1, At, B1); PG8_BAR; PG8_SCHED;
        }
        if (wr == 0) PG8_BAR;
        E(acc, cur, ui, wr, wc, fr, fq);
        if (!has_next) break;
#pragma unroll
        for (int a = 0; a < 2; ++a)
#pragma unroll
            for (int b = 0; b < 2; ++b)
#pragma unroll
                for (int m = 0; m < 4; ++m)
#pragma unroll
                    for (int n = 0; n < 2; ++n) acc[a][b][m][n] = (f32x4){0.f, 0.f, 0.f, 0.f};
        cur = nxt; cA = nA; cB = nB; ++ui;
        if (wr == 1) PG8_BAR;
    }
    PG8_WAIT_V(0);
    PG8_BAR;
#undef PG8_SA
#undef PG8_SB
#undef PG8_STAGE
#undef PG8_LDA
#undef PG8_LDB
#undef PG8_MMA
#undef PG8_WAIT_V
#undef PG8_WAIT_L
#undef PG8_BAR
#undef PG8_SCHED
}
}
using pg8::Unit;

DI void rope4(f32x4& v0, f32x4& v1, const f32x4 cs0, const f32x4 cs1) {
    f32x4 a = v0, b = v1;
    v0[0] = a[0] * cs0[0] - a[1] * cs0[1]; v0[1] = a[1] * cs0[0] + a[0] * cs0[1];
    v0[2] = a[2] * cs0[2] - a[3] * cs0[3]; v0[3] = a[3] * cs0[2] + a[2] * cs0[3];
    v1[0] = b[0] * cs1[0] - b[1] * cs1[1]; v1[1] = b[1] * cs1[0] + b[0] * cs1[1];
    v1[2] = b[2] * cs1[2] - b[3] * cs1[3]; v1[3] = b[3] * cs1[2] + b[2] * cs1[3];
}
DI void store8(bf16_t* p, const f32x4 v0, const f32x4 v1) {
    u32x4 w; w.x = cvtpk(v0[0], v0[1]); w.y = cvtpk(v0[2], v0[3]); w.z = cvtpk(v1[0], v1[1]); w.w = cvtpk(v1[2], v1[3]);
    *(u32x4*)p = w;
}

struct EpiProj {
    bf16_t* O; const float* ropeA; const float* ropeB; float* ssqq; float* ssqkv;
    DI void hook(f32x4 (&)[2][2][4][2], int, int, int, int) const {}
    DI void operator()(const f32x4 (&acc)[2][2][4][2], const Unit& u, int ui, int wr, int wc, int fr, int fq) const {
        const int row0 = u.pm * 256 + wr * 64 + fr, col0 = u.pn * 256 + wc * 32 + 8 * fq;
        const bool rA = (u.pn < 8) && ((wc & 1) == 0) && (fq < 2);
        const bool rB = (u.pn == 23) && (wc == 0);
        const bool sq = (u.pn >= 22);
#pragma unroll
        for (int ai = 0; ai < 2; ++ai)
#pragma unroll
            for (int m = 0; m < 4; ++m) {
                const int row = row0 + ai * 128 + m * 16;
                f32x4 ca0, ca1, cb0, cb1;
                if (rA) { ca0 = *(const f32x4*)(ropeA + (size_t)row * 16 + 8 * fq); ca1 = *(const f32x4*)(ropeA + (size_t)row * 16 + 8 * fq + 4); }
                if (rB) { cb0 = *(const f32x4*)(ropeB + (size_t)row * 32 + 8 * fq); cb1 = *(const f32x4*)(ropeB + (size_t)row * 32 + 8 * fq + 4); }
                float s0 = 0.f, s1 = 0.f;
#pragma unroll
                for (int bj = 0; bj < 2; ++bj) {
                    f32x4 v0 = acc[ai][bj][m][0], v1 = acc[ai][bj][m][1];
                    const float q = (v0[0] * v0[0] + v0[1] * v0[1]) + (v0[2] * v0[2] + v0[3] * v0[3]) + (v1[0] * v1[0] + v1[1] * v1[1]) + (v1[2] * v1[2] + v1[3] * v1[3]);
                    if (bj == 0) s0 = q; else s1 = q;
                    if (rA) rope4(v0, v1, ca0, ca1);
                    if (rB && bj == 1) rope4(v0, v1, cb0, cb1);
                    store8(O + (size_t)row * NP + col0 + bj * 128, v0, v1);
                }
                if (sq) {
                    float s = (u.pn == 22) ? (s0 + s1) : s0;
                    s += __shfl_xor(s, 16); s += __shfl_xor(s, 32);
                    if (fq == 0) { float* d = (u.pn == 22) ? ssqq : ssqkv; d[(size_t)row * 4 + wc] = s; }
                }
            }
    }
};
struct EpiQ {
    bf16_t* O; const float* ropeB; const float* ssqq;
    DI void hook(f32x4 (&)[2][2][4][2], int, int, int, int) const {}
    DI void operator()(const f32x4 (&acc)[2][2][4][2], const Unit& u, int ui, int wr, int wc, int fr, int fq) const {
        const int row0 = u.pm * 256 + wr * 64 + fr, col0 = u.pn * 256 + wc * 32 + 8 * fq;
#pragma unroll
        for (int ai = 0; ai < 2; ++ai)
#pragma unroll
            for (int m = 0; m < 4; ++m) {
                const int row = row0 + ai * 128 + m * 16;
                const f32x4 sq = *(const f32x4*)(ssqq + (size_t)row * 4);
                const float rs = __builtin_amdgcn_rsqf(((sq[0] + sq[1]) + (sq[2] + sq[3])) * (1.0f / 256.0f) + EPS);
#pragma unroll
                for (int bj = 0; bj < 2; ++bj) {
                    f32x4 v0 = acc[ai][bj][m][0] * rs, v1 = acc[ai][bj][m][1] * rs;
                    const int cg0 = u.pn * 256 + bj * 128 + wc * 32;
                    if ((cg0 % 96) == 64) { const f32x4 cb0 = *(const f32x4*)(ropeB + (size_t)row * 32 + 8 * fq), cb1 = *(const f32x4*)(ropeB + (size_t)row * 32 + 8 * fq + 4); rope4(v0, v1, cb0, cb1); }
                    store8(O + (size_t)row * 768 + col0 + bj * 128, v0, v1);
                }
                asm volatile("" ::: "memory");
            }
    }
};
struct EpiKV {
    bf16_t* O; const float* ssqkv;
    DI void hook(f32x4 (&)[2][2][4][2], int, int, int, int) const {}
    DI void operator()(const f32x4 (&acc)[2][2][4][2], const Unit& u, int ui, int wr, int wc, int fr, int fq) const {
        const int row0 = u.pm * 256 + wr * 64 + fr, col0 = u.pn * 256 + wc * 32 + 8 * fq;
#pragma unroll
        for (int ai = 0; ai < 2; ++ai)
#pragma unroll
            for (int m = 0; m < 4; ++m) {
                const int row = row0 + ai * 128 + m * 16;
                const f32x4 sq = *(const f32x4*)(ssqkv + (size_t)row * 4);
                const float rs = __builtin_amdgcn_rsqf(((sq[0] + sq[1]) + (sq[2] + sq[3])) * (1.0f / 128.0f) + EPS);
#pragma unroll
                for (int bj = 0; bj < 2; ++bj) store8(O + (size_t)row * 1024 + col0 + bj * 128, acc[ai][bj][m][0] * rs, acc[ai][bj][m][1] * rs);
                asm volatile("" ::: "memory");
            }
    }
};
struct EpiPlain {
    bf16_t* O; int ldc;
    DI void hook(f32x4 (&)[2][2][4][2], int, int, int, int) const {}
    DI void operator()(const f32x4 (&acc)[2][2][4][2], const Unit& u, int ui, int wr, int wc, int fr, int fq) const {
        const int row0 = u.pm * 256 + wr * 64 + fr, col0 = u.pn * 256 + wc * 32 + 8 * fq;
#pragma unroll
        for (int ai = 0; ai < 2; ++ai)
#pragma unroll
            for (int m = 0; m < 4; ++m) {
                const int row = row0 + ai * 128 + m * 16;
#pragma unroll
                for (int bj = 0; bj < 2; ++bj) store8(O + (size_t)row * ldc + col0 + bj * 128, acc[ai][bj][m][0], acc[ai][bj][m][1]);
            }
    }
};
struct EpiOut {
    bf16_t* stage; const bf16_t* hb; float* pstat;
    const LAS f32x4* rtab;
    DI void hook(f32x4 (&acc)[2][2][4][2], int ui, int t, int wr, int fr) const {
#pragma unroll
        for (int ai = 0; ai < 2; ++ai)
#pragma unroll
            for (int m = 0; m < 4; ++m) {
                const f32x4 r = rtab[ui * 256 + ai * 128 + wr * 64 + m * 16 + fr];
                const float f = (t == 16) ? r[0] : r[1];
#pragma unroll
                for (int bj = 0; bj < 2; ++bj) { acc[ai][bj][m][0] = acc[ai][bj][m][0] * f; acc[ai][bj][m][1] = acc[ai][bj][m][1] * f; }
            }
    }
    DI void operator()(const f32x4 (&acc)[2][2][4][2], const Unit& u, int ui, int wr, int wc, int fr, int fq) const {
        const int col0 = u.pn * 256 + wc * 32 + 8 * fq;
#pragma unroll
        for (int ai = 0; ai < 2; ++ai)
#pragma unroll
            for (int m = 0; m < 4; ++m) {
                const int rl = ai * 128 + wr * 64 + m * 16 + fr, row = u.pm * 256 + rl;
                const float rsm = rtab[ui * 256 + rl][2];
                float s = 0.f, q = 0.f;
#pragma unroll
                for (int bj = 0; bj < 2; ++bj) {
                    const u32x4 hw = *(const u32x4*)(hb + (size_t)row * DM + col0 + bj * 128);
                    const f32x4 h0 = {__builtin_bit_cast(float, hw.x << 16), __builtin_bit_cast(float, hw.x & 0xffff0000u), __builtin_bit_cast(float, hw.y << 16), __builtin_bit_cast(float, hw.y & 0xffff0000u)};
                    const f32x4 h1 = {__builtin_bit_cast(float, hw.z << 16), __builtin_bit_cast(float, hw.z & 0xffff0000u), __builtin_bit_cast(float, hw.w << 16), __builtin_bit_cast(float, hw.w & 0xffff0000u)};
                    const f32x4 v0 = acc[ai][bj][m][0] * rsm + h0 * ALPHA, v1 = acc[ai][bj][m][1] * rsm + h1 * ALPHA;
                    store8(stage + (size_t)row * NP + col0 + bj * 128, v0, v1);
                    s += ((v0[0] + v0[1]) + (v0[2] + v0[3])) + ((v1[0] + v1[1]) + (v1[2] + v1[3]));
                    q += ((v0[0] * v0[0] + v0[1] * v0[1]) + (v0[2] * v0[2] + v0[3] * v0[3])) + ((v1[0] * v1[0] + v1[1] * v1[1]) + (v1[2] * v1[2] + v1[3] * v1[3]));
                }
                s += __shfl_xor(s, 16); s += __shfl_xor(s, 32); q += __shfl_xor(q, 16); q += __shfl_xor(q, 32);
                if (fq == 0) *(f32x2*)(pstat + ((size_t)row * 16 + u.pn * 4 + wc) * 2) = (f32x2){s, q};
            }
    }
};

DI float xhalf_max(float x) { float a = x, b = x; asm volatile("s_nop 1\n\tv_permlane32_swap_b32 %0, %1" : "+v"(a), "+v"(b)); return fmaxf(a, b); }
#define MFMA32(a, b, c) __builtin_amdgcn_mfma_f32_32x32x16_bf16((a), (b), (c), 0, 0, 0)
DI int crow(int reg, int h) { return (reg & 3) + 8 * (reg >> 2) + 4 * h; }
DI s16x4 vtr(const LAS char* p) { return __builtin_bit_cast(s16x4, __builtin_amdgcn_ds_read_tr16_b64_v4i16((LAS s16x4*)p)); }
DI bf16x8 pack8(const f32x16& x, int s) {
    u32x4 p; p.x = cvtpk(x[8 * s], x[8 * s + 1]); p.y = cvtpk(x[8 * s + 2], x[8 * s + 3]); p.z = cvtpk(x[8 * s + 4], x[8 * s + 5]); p.w = cvtpk(x[8 * s + 6], x[8 * s + 7]);
    return __builtin_bit_cast(bf16x8, p);
}
DI float max16(const f32x16& s) {
    float a = fmaxf(fmaxf(s[0], s[1]), fmaxf(s[2], s[3])), b = fmaxf(fmaxf(s[4], s[5]), fmaxf(s[6], s[7]));
    float c = fmaxf(fmaxf(s[8], s[9]), fmaxf(s[10], s[11])), d = fmaxf(fmaxf(s[12], s[13]), fmaxf(s[14], s[15]));
    return fmaxf(fmaxf(a, b), fmaxf(c, d));
}


template <int DV>
DI void epi_rows(LAS float* buf, const f32x16* o, float inv, bf16_t* gy0  , int gp, float* ssq0, int lane) {
    constexpr int P = DV + 4, CH = DV / 8, RPI = 64 / CH, NIT = 32 / RPI;
    const int r32 = lane & 31, h = lane >> 5;
#pragma unroll
    for (int d = 0; d < DV / 32; ++d)
#pragma unroll
        for (int g = 0; g < 4; ++g) *(LAS f32x4*)(buf + r32 * P + 32 * d + 8 * g + 4 * h) = (f32x4){o[d][4 * g] * inv, o[d][4 * g + 1] * inv, o[d][4 * g + 2] * inv, o[d][4 * g + 3] * inv};
    asm volatile("" ::: "memory");
    const int c = lane % CH, q0 = lane / CH;
#pragma unroll
    for (int i = 0; i < NIT; ++i) {
        const int q = q0 + RPI * i;
        const f32x4 a0 = *(const LAS f32x4*)(buf + q * P + 8 * c), a1 = *(const LAS f32x4*)(buf + q * P + 8 * c + 4);
        bf16_t* gy = gy0 + (size_t)q * gp + 8 * c;
        const u32x4 gw = *(const u32x4*)gy;
        float sq = (a0[0] * a0[0] + a0[1] * a0[1]) + (a0[2] * a0[2] + a0[3] * a0[3]) + (a1[0] * a1[0] + a1[1] * a1[1]) + (a1[2] * a1[2] + a1[3] * a1[3]);
#pragma unroll
        for (int m = 1; m < CH; m <<= 1) sq += __shfl_xor(sq, m);
        u32x4 ow;
        ow.x = cvtpk(a0[0] * silu(__builtin_bit_cast(float, gw.x << 16)), a0[1] * silu(__builtin_bit_cast(float, gw.x & 0xffff0000u)));
        ow.y = cvtpk(a0[2] * silu(__builtin_bit_cast(float, gw.y << 16)), a0[3] * silu(__builtin_bit_cast(float, gw.y & 0xffff0000u)));
        ow.z = cvtpk(a1[0] * silu(__builtin_bit_cast(float, gw.z << 16)), a1[1] * silu(__builtin_bit_cast(float, gw.z & 0xffff0000u)));
        ow.w = cvtpk(a1[2] * silu(__builtin_bit_cast(float, gw.w << 16)), a1[3] * silu(__builtin_bit_cast(float, gw.w & 0xffff0000u)));
        *(u32x4*)gy = ow;
        if (c == 0) ssq0[(size_t)q * 32] = sq;
    }
    asm volatile("" ::: "memory");
}

template <int DQK, int D1, int DV, int QT>
DI void attn_dense_unit(LAS char* lds, const bf16_t* q, int qp, const bf16_t* k1, int k1p, const bf16_t* k2, int k2p, const bf16_t* v, int vp, int nkeys,
                        bf16_t* gate_y, int gp, float* ssq  ) {
    constexpr int KP = DQK * 2 + 16, VP = DV * 2 + (DV == 64 ? 16 : 32);
    constexpr int KT = 64 * KP, VT = 64 * VP, BUF = KT + VT;
    constexpr int KCH = DQK / 8, VCH = DV / 8, NKC = 64 * KCH, NVC = 64 * VCH;
    constexpr int KI = (NKC + NTHREADS - 1) / NTHREADS, VI = (NVC + NTHREADS - 1) / NTHREADS;
    constexpr int NKS = DQK / 16, NDT = DV / 32;
    int tid_ = threadIdx.x; asm volatile("" : "+v"(tid_));
    const int tid = tid_, lane = tid & 63, w = __builtin_amdgcn_readfirstlane(tid >> 6), r32 = lane & 31, h = lane >> 5;
    bf16x8 qf[QT][NKS];
#pragma unroll
    for (int qt = 0; qt < QT; ++qt) { const bf16_t* qr = q + (size_t)((w * QT + qt) * 32 + r32) * qp + 8 * h;
#pragma unroll
      for (int s = 0; s < NKS; ++s) qf[qt][s] = *(const bf16x8*)(qr + 16 * s); }
    u32x4 kreg[KI], vreg[VI];
    auto load_regs = [&](int t) {
#pragma unroll
        for (int i = 0; i < KI; ++i) { const int c = tid + i * NTHREADS; if (NKC % NTHREADS == 0 || c < NKC) { const int r = c / KCH, j = c % KCH; const size_t row = (size_t)(t * 64 + r);
            kreg[i] = (j * 8 < D1) ? *(const u32x4*)(k1 + row * k1p + j * 8) : *(const u32x4*)(k2 + row * k2p + (j * 8 - D1)); } }
#pragma unroll
        for (int i = 0; i < VI; ++i) { const int c = tid + i * NTHREADS; if (NVC % NTHREADS == 0 || c < NVC) { const int r = c / VCH, j = c % VCH; vreg[i] = *(const u32x4*)(v + (size_t)(t * 64 + r) * vp + j * 8); } }
    };
    auto store_lds = [&](int b) {
        LAS char* kb = lds + b * BUF; LAS char* vb = kb + KT;
#pragma unroll
        for (int i = 0; i < KI; ++i) { const int c = tid + i * NTHREADS; if (NKC % NTHREADS == 0 || c < NKC) { const int r = c / KCH, j = c % KCH; *(LAS u32x4*)(kb + r * KP + j * 16) = kreg[i]; } }
#pragma unroll
        for (int i = 0; i < VI; ++i) { const int c = tid + i * NTHREADS; if (NVC % NTHREADS == 0 || c < NVC) { const int r = c / VCH, j = c % VCH; *(LAS u32x4*)(vb + r * VP + j * 16) = vreg[i]; } }
    };
    f32x16 o[QT][NDT]; float mrun[QT], lrun[QT];
#pragma unroll
    for (int qt = 0; qt < QT; ++qt) { mrun[qt] = NEGBIG; lrun[qt] = 0.f;
#pragma unroll
        for (int d = 0; d < NDT; ++d)
#pragma unroll
            for (int i = 0; i < 16; ++i) o[qt][d][i] = 0.f; }
    const int i16 = lane & 15, tq = i16 >> 2, tp = i16 & 3, blk = (lane >> 4) & 1;
    const int voff = (4 * h + tq) * VP + (16 * blk + 4 * tp) * 2;
    const int NT = nkeys / 64;
    load_regs(0); store_lds(0);
#pragma unroll
    for (int qt = 0; qt < QT; ++qt)
#pragma unroll
        for (int s = 0; s < NKS; ++s) asm volatile("" : "+v"(qf[qt][s]));
    __syncthreads();
    for (int t = 0; t < NT; ++t) {
        if (t + 1 < NT) load_regs(t + 1);
        const LAS char* kb = lds + (t & 1) * BUF; const LAS char* vb = kb + KT;
#pragma unroll
        for (int sub = 0; sub < 2; ++sub) {
            f32x16 sc[QT];
#pragma unroll
            for (int qt = 0; qt < QT; ++qt)
#pragma unroll
                for (int i = 0; i < 16; ++i) sc[qt][i] = 0.f;
            __builtin_amdgcn_s_setprio(1);
#pragma unroll
            for (int s = 0; s < NKS; ++s) {
                const bf16x8 a0 = *(const LAS bf16x8*)(kb + (32 * sub + r32) * KP + (16 * s + 8 * h) * 2);
#pragma unroll
                for (int qt = 0; qt < QT; ++qt) sc[qt] = MFMA32(a0, qf[qt][s], sc[qt]);
            }
            __builtin_amdgcn_s_setprio(0);
            bf16x8 pb[QT][2];
#pragma unroll
            for (int qt = 0; qt < QT; ++qt) {
                float mx = max16(sc[qt]); mx = xhalf_max(mx);
                const float mnew = fmaxf(mrun[qt], mx);
                if (__builtin_amdgcn_ballot_w64(mnew > mrun[qt]) != 0ull) {
                    const float alpha = fast_exp2(mrun[qt] - mnew); lrun[qt] = lrun[qt] * alpha;
#pragma unroll
                    for (int d = 0; d < NDT; ++d) o[qt][d] = o[qt][d] * alpha;
                }
                mrun[qt] = mnew;
                float rs = 0.f;
#pragma unroll
                for (int i = 0; i < 16; ++i) { sc[qt][i] = fast_exp2(sc[qt][i] - mnew); rs += sc[qt][i]; }
                lrun[qt] = lrun[qt] + rs;
                pb[qt][0] = pack8(sc[qt], 0); pb[qt][1] = pack8(sc[qt], 1);
            }
#pragma unroll
            for (int ks = 0; ks < 2; ++ks) {
                const LAS char* vr = vb + voff + (32 * sub + 16 * ks) * VP;
#pragma unroll
                for (int d = 0; d < NDT; ++d) {
                    const s16x4 lo = vtr(vr + d * 64), hi = vtr(vr + 8 * VP + d * 64);
                    const bf16x8 va = __builtin_shufflevector(lo, hi, 0, 1, 2, 3, 4, 5, 6, 7);
#pragma unroll
                    for (int qt = 0; qt < QT; ++qt) o[qt][d] = MFMA32(va, pb[qt][ks], o[qt][d]);
                }
            }
        }
        if (t + 1 < NT) store_lds((t + 1) & 1);
        __syncthreads();
    }
#pragma unroll
    for (int qt = 0; qt < QT; ++qt) {
        const float ltot = lrun[qt] + __shfl_xor(lrun[qt], 32), inv = 1.0f / ltot;
        const int row0 = (w * QT + qt) * 32;
        epi_rows<DV>((LAS float*)(lds + w * (32 * (DV + 4) * 4)), o[qt], inv, gate_y + (size_t)row0 * gp, gp, ssq + (size_t)row0 * 32, lane);
    }
    __syncthreads();
}

constexpr int A_OSTP = 64;
DI int a_swz(int row, int chunk) { return ((chunk ^ row ^ (row >> 4)) & 15) * 4; }
constexpr int A_ML_OFF = 256 * A_OSTP * 4, A_VW_OFF = A_ML_OFF + 2048, A_VP = 144, A_VWB = 2 * 32 * A_VP;
struct APf { u32x4 kc[4], vc[4]; bf16x8 qf[4]; };
template <int DIL> DI void a_geom(int P0, int w, int r32, int& qpos, int& kb0) {
    if (DIL == 16) { const int cls = w + 8 * (r32 >> 4); qpos = P0 + cls + 16 * (r32 & 15); kb0 = 0; }
    else if (DIL == 4) { const int base = P0 + 128 * (w >> 2) + (w & 3); qpos = base + 4 * r32; kb0 = base - 256; }
    else { const int base = P0 + 32 * w; qpos = base + r32; kb0 = base - 64; }
}
template <int DIL> DI int a_kbase(int w, int kb0, int i) { if (DIL == 16) return (w + 8 * (i >> 2)) + 512 * (i & 3); else return kb0 + DIL * 32 * i; }
DI int a_clamp(int p) { return p < 0 ? 0 : (p > SEQ - 1 ? SEQ - 1 : p); }
template <int DIL> DI void a_issue_kv(APf& pf, const bf16_t* prow, int kb, int lane) {
    const int kbs = __builtin_amdgcn_readfirstlane(((unsigned)kb < (unsigned)SEQ) ? kb : 0);
    const char* sb = (const char*)(prow + (size_t)kbs * NP);
#pragma unroll
    for (int j = 0; j < 4; ++j) { const int c = lane + 64 * j, r = c >> 3, ch = c & 7; const unsigned vo = (unsigned)(DIL * r * NP + 8 * ch) * 2u;
        pf.kc[j] = *(const u32x4*)(sb + vo + C_AK * 2); pf.vc[j] = *(const u32x4*)(sb + vo + C_AV * 2); }
}
template <int DIL> DI void a_first_issue(APf& pf, const bf16_t* prow, int P0, int w, int lane) {
    const int r32 = lane & 31, h = lane >> 5; int qpos, kb0; a_geom<DIL>(P0, w, r32, qpos, kb0);
    const bf16_t* qr = prow + (size_t)qpos * NP + C_AQ + 8 * h;
#pragma unroll
    for (int s = 0; s < 4; ++s) pf.qf[s] = *(const bf16x8*)(qr + 16 * s);
    a_issue_kv<DIL>(pf, prow, a_kbase<DIL>(w, kb0, 0), lane);
}
template <int DIL, int PASS, class NextFn>
DI void attnA_pass(LAS char* lds, const bf16_t* prow  , float* ssq  , int P0, int w, int lane_, APf& pf, NextFn next_issue) {
    int lane = lane_; asm volatile("" : "+v"(lane));
    const int r32 = lane & 31, h = lane >> 5;
    int qpos, kb0; constexpr int NSUB = (DIL == 16) ? 8 : 5;
    a_geom<DIL>(P0, w, r32, qpos, kb0);
    const int qloc = qpos - P0;
    LAS float* ost = (LAS float*)lds; LAS float* ml = (LAS float*)(lds + A_ML_OFF); LAS char* vw = lds + A_VW_OFF + w * A_VWB;
    f32x16 o[2]; float mrun, lrun;
    if (PASS == 0) {
#pragma unroll
        for (int d = 0; d < 2; ++d)
#pragma unroll
            for (int i = 0; i < 16; ++i) o[d][i] = 0.f;
        mrun = NEGBIG; lrun = 0.f;
    } else {
#pragma unroll
        for (int d = 0; d < 2; ++d)
#pragma unroll
            for (int g = 0; g < 4; ++g) { const f32x4 t4 = *(const LAS f32x4*)(ost + qloc * A_OSTP + a_swz(qloc, 8 * d + 2 * g + h)); o[d][4 * g] = t4[0]; o[d][4 * g + 1] = t4[1]; o[d][4 * g + 2] = t4[2]; o[d][4 * g + 3] = t4[3]; }
        const f32x2 mlv = *(const LAS f32x2*)(ml + qloc * 2); mrun = mlv[0]; lrun = (h == 0) ? mlv[1] : 0.f;
    }
    auto kbase_of = [&](int i) -> int { return a_kbase<DIL>(w, kb0, i); };
    LAS char* kw = vw; LAS char* vw2 = vw + 32 * A_VP;
    auto issue = [&](int i) { a_issue_kv<DIL>(pf, prow, kbase_of(i), lane); };
    auto vstore = [&]() {
#pragma unroll
        for (int j = 0; j < 4; ++j) { const int c = lane + 64 * j, r = c >> 3, ch = c & 7; *(LAS u32x4*)(kw + r * A_VP + ch * 16) = pf.kc[j]; *(LAS u32x4*)(vw2 + r * A_VP + ch * 16) = pf.vc[j]; }
        asm volatile("" ::: "memory");
    };
    const int i16 = lane & 15, tq = i16 >> 2, tp = i16 & 3, blk = (lane >> 4) & 1;
    const int voff = (4 * h + tq) * A_VP + (16 * blk + 4 * tp) * 2;
    const int koff = r32 * A_VP + 16 * h;
    APf pb2;
    a_issue_kv<DIL>(pb2, prow, kbase_of(1), lane);
    auto vstoreB = [&]() {
#pragma unroll
        for (int j = 0; j < 4; ++j) { const int c = lane + 64 * j, r = c >> 3, ch = c & 7; *(LAS u32x4*)(kw + r * A_VP + ch * 16) = pb2.kc[j]; *(LAS u32x4*)(vw2 + r * A_VP + ch * 16) = pb2.vc[j]; }
        asm volatile("" ::: "memory");
    };
    bf16x8 qf[4];
#pragma unroll
    for (int s = 0; s < 4; ++s) qf[s] = pf.qf[s];
    auto compute = [&](int i) {
        const int kb = kbase_of(i);
        bool live;
        if (DIL == 16) { const int t0 = 32 * (i & 3), b16 = P0 >> 4; live = (t0 + 31 >= b16 - 64) && (t0 <= b16 + 79); }
        else live = (unsigned)kb < (unsigned)SEQ;
        if (live) {
        f32x16 st;
#pragma unroll
        for (int j = 0; j < 16; ++j) st[j] = 0.f;
#pragma unroll
        for (int s = 0; s < 4; ++s) { const bf16x8 ka = *(const LAS bf16x8*)(kw + koff + 32 * s); st = MFMA32(ka, qf[s], st); }
        if (DIL == 16) {
            const bool cm = ((i >> 2) == (r32 >> 4));
            const int jq = (P0 >> 4) + (r32 & 15);
            const int tt = cm ? (32 * (i & 3) + 4 * h - jq + 64) : 0x40000000;
#pragma unroll
            for (int j = 0; j < 16; ++j) st[j] = ((unsigned)(tt + ((j & 3) + 8 * (j >> 2))) <= 128u) ? st[j] : NEGBIG;
        } else if (i == 0) {
#pragma unroll
            for (int j = 0; j < 16; ++j) st[j] = (crow(j, h) >= r32) ? st[j] : NEGBIG;
        } else if (i == 4) {
#pragma unroll
            for (int j = 0; j < 16; ++j) st[j] = (crow(j, h) <= r32) ? st[j] : NEGBIG;
        }
        float mx = max16(st); mx = xhalf_max(mx);
        const float mnew = fmaxf(mrun, mx);
        if (__builtin_amdgcn_ballot_w64(mnew > mrun) != 0ull) { const float alpha = fast_exp2(mrun - mnew); lrun = lrun * alpha; o[0] = o[0] * alpha; o[1] = o[1] * alpha; }
        mrun = mnew;
        float rs = 0.f;
#pragma unroll
        for (int j = 0; j < 16; ++j) { st[j] = fast_exp2(st[j] - mnew); rs += st[j]; }
        lrun = lrun + rs;
#pragma unroll
        for (int ks = 0; ks < 2; ++ks) {
            const bf16x8 pb = pack8(st, ks);
            const LAS char* vr = vw2 + voff + (16 * ks) * A_VP;
#pragma unroll
            for (int d = 0; d < 2; ++d) {
                const s16x4 lo = vtr(vr + d * 64), hi = vtr(vr + 8 * A_VP + d * 64);
                const bf16x8 va = __builtin_shufflevector(lo, hi, 0, 1, 2, 3, 4, 5, 6, 7);
                o[d] = MFMA32(va, pb, o[d]);
            }
        }
        }
        asm volatile("" ::: "memory");
    };
    vstore();
#pragma unroll
    for (int s = 0; s < 4; ++s) asm volatile("" : "+v"(qf[s]));
    if (2 < NSUB) issue(2);
    compute(0);
#pragma unroll 1
    for (int i = 1; i < NSUB; i += 2) {
        vstoreB(); if (i + 2 < NSUB) a_issue_kv<DIL>(pb2, prow, kbase_of(i + 2), lane); compute(i);
        if (i + 1 < NSUB) { vstore(); if (i + 3 < NSUB) issue(i + 3); compute(i + 1); }
    }
    next_issue();
    if (PASS < 2) {
#pragma unroll
        for (int d = 0; d < 2; ++d)
#pragma unroll
            for (int g = 0; g < 4; ++g) *(LAS f32x4*)(ost + qloc * A_OSTP + a_swz(qloc, 8 * d + 2 * g + h)) = (f32x4){o[d][4 * g], o[d][4 * g + 1], o[d][4 * g + 2], o[d][4 * g + 3]};
        const float ltot = lrun + __shfl_xor(lrun, 32);
        if (h == 0) *(LAS f32x2*)(ml + qloc * 2) = (f32x2){mrun, ltot};
    } else {
        const float ltot = lrun + __shfl_xor(lrun, 32), inv = 1.0f / ltot;
        const int q0pos = qpos - r32;
        epi_rows<64>((LAS float*)vw, o, inv, (bf16_t*)prow + (size_t)q0pos * NP + C_AG, NP, ssq + (size_t)q0pos * 32, lane);
    }
}

DI int win_dst(int n, float& scale) {
    scale = 1.0f;
    if (n < 2048) { const int d = n & 63, base = n - d; if (n < 1024) scale = 0.125f * LOG2E; return base + (d < 16 ? ((d & 7) * 2 + (d >> 3)) : d); }
    if (n < 4096) return n;
    if (n < 4352) return C_CQ + (n - 4096);
    if (n < 4480) return C_CKV + (n - 4352);
    if (n < 4512) { const int d = n - 4480; return C_KR + ((d & 15) * 2 + (d >> 4)); }
    if (n < 5024) return C_BG + (n - 4512);
    if (n < 5536) { scale = 0.08838834764831845f * LOG2E; return C_MQ + (n - 5024); }
    return C_MG + (n - 5536);
}
template <int MODE>
DI void tr_item(const float* W, int K, int N, bf16_t* WT, const float* g0, const float* g1, const float* g2, LAS float* scr, int item, int lane) {
    const int nblk = N / 32, kb = item / nblk, nb = item % nblk, k0 = 64 * kb, n0 = 32 * nb;
    float wv[32];
#pragma unroll
    for (int i = 0; i < 32; ++i) { const int kk = 2 * i + (lane >> 5); wv[i] = W[(size_t)(k0 + kk) * N + n0 + (lane & 31)]; }
#pragma unroll
    for (int i = 0; i < 32; ++i) { const int kk = 2 * i + (lane >> 5); scr[kk * 33 + (lane & 31)] = wv[i]; }
    asm volatile("s_waitcnt lgkmcnt(0)" ::: "memory");
    const int c = lane & 7;
    float gk[8];
#pragma unroll
    for (int e = 0; e < 8; ++e) { const int k = k0 + 8 * c + e;
        if (MODE == 1 || MODE == 2) gk[e] = g0[k];
        else if (MODE == 4) gk[e] = (k < 1024) ? g0[k] : (k < 1536 ? g1[k - 1024] : g2[k - 1536]);
        else gk[e] = 1.0f; }
#pragma unroll
    for (int j = 0; j < 4; ++j) {
        const int nl = (lane >> 3) + 8 * j, n = n0 + nl; float sc = 1.0f; int dst = n;
        if (MODE == 0) dst = win_dst(n, sc);
        if (MODE == 1) { const int hd = n / 96, d = n % 96; sc = 0.10206207261596575f * LOG2E; if (d >= 64) { const int r = d - 64; dst = hd * 96 + 64 + ((r & 15) * 2 + (r >> 4)); } }
        const LAS float* s = scr + (8 * c) * 33 + nl;
        u32x4 o4; o4.x = cvtpk(s[0 * 33] * gk[0] * sc, s[1 * 33] * gk[1] * sc); o4.y = cvtpk(s[2 * 33] * gk[2] * sc, s[3 * 33] * gk[3] * sc);
        o4.z = cvtpk(s[4 * 33] * gk[4] * sc, s[5 * 33] * gk[5] * sc); o4.w = cvtpk(s[6 * 33] * gk[6] * sc, s[7 * 33] * gk[7] * sc);
        *(u32x4*)(WT + (size_t)dst * K + k0 + 8 * c) = o4;
    }
    asm volatile("s_waitcnt lgkmcnt(0)" ::: "memory");
}

__constant__ double INVF_A[8] = {1.0, 0.19390103887252767, 0.037597612875247145, 0.007290216193692821, 0.0014135804504232794, 0.00027409471785274054, 5.3147250536566735e-05, 1.0305307092165658e-05};
__constant__ double INVF_B[16] = {1.0, 0.44034195675670255, 0.19390103887252767, 0.08538276288621138, 0.037597612875247145, 0.016555806424970463, 0.007290216193692821, 0.0032101880639213203,
                                  0.0014135804504232794, 0.0006224587813827168, 0.00027409471785274054, 0.00012069540440475095, 5.3147250536566735e-05, 2.3402964294289857e-05, 1.0305307092165658e-05, 4.537859090181327e-06};


#define XB_TMO      128
#define XB_XCNT(j)  (256  + 64 * (j))
#define XB_XSUB(j)  (1280 + 64 * (j))
#define XB_XGEN(j)  (2304 + 64 * (j))
#define XB_TOP      3328
#define XB_TOPGEN   3392
#define XCD_BAR_WORDS 3456
#define XB_SPIN_CAP (1u << 18)
DI unsigned xb_ld(unsigned* p)              { return __hip_atomic_load(p, __ATOMIC_RELAXED, __HIP_MEMORY_SCOPE_AGENT); }
DI unsigned xb_add(unsigned* p, unsigned v) { return __hip_atomic_fetch_add(p, v, __ATOMIC_RELAXED, __HIP_MEMORY_SCOPE_AGENT); }
DI unsigned xb_xcc_id() { return (unsigned)__builtin_amdgcn_s_getreg((3 << 11) | 20) & 0xFu; }
#define XB_SPIN(cond, bar) do { unsigned _sp = 0; while (cond) { __builtin_amdgcn_s_sleep(1); \
    if ((++_sp & 255u) == 0u) { if (xb_ld(&(bar)[XB_TMO])) break; if (_sp > XB_SPIN_CAP) { atomicAdd(&(bar)[XB_TMO], 1u); break; } } } } while (0)
struct XcdBarrier { unsigned* bar; unsigned x; volatile LAS unsigned* st; };
DI XcdBarrier xcd_barrier_post(unsigned* bar, volatile LAS unsigned* st) {
    XcdBarrier b; b.bar = bar; b.x = xb_xcc_id(); b.st = st;
    if (threadIdx.x == 0) (void)xb_add(&bar[XB_XCNT(b.x)], 1u);
    return b;
}
DI void xcd_barrier_complete(unsigned* bar, unsigned x, unsigned& nloc, unsigned& nx) {
    const unsigned G = gridDim.x * gridDim.y * gridDim.z;
    unsigned sum, cnt, mine, sp = 0u;
    for (;;) {
        sum = 0u; cnt = 0u; mine = 0u;
#pragma unroll
        for (unsigned j = 0; j < 16; ++j) { const unsigned c = xb_ld(&bar[XB_XCNT(j)]); sum += c; cnt += (c > 0u) ? 1u : 0u; mine = (j == x) ? c : mine; }
        if (sum == G) break;
        __builtin_amdgcn_s_sleep(1);
        if ((++sp & 255u) == 0u) { if (xb_ld(&bar[XB_TMO])) break; if (sp > XB_SPIN_CAP) { atomicAdd(&bar[XB_TMO], 1u); break; } }
    }
    nloc = mine > 0u ? mine : 1u; nx = cnt > 0u ? cnt : 1u;
}
DI void xcd_barrier(const XcdBarrier& b) {
    asm volatile("s_waitcnt vmcnt(0)" ::: "memory");
    __syncthreads();
    if (threadIdx.x == 0) {
        unsigned* bar = b.bar;
        __builtin_amdgcn_s_waitcnt(0);
        unsigned nloc = b.st[0], nx = b.st[1];
        if (nloc == 0u) { xcd_barrier_complete(bar, b.x, nloc, nx); b.st[0] = nloc; b.st[1] = nx; }
        const unsigned old = xb_add(&bar[XB_XSUB(b.x)], 1u);
        const unsigned gen = old / nloc;
        if (old + 1u == (gen + 1u) * nloc) {
            __builtin_amdgcn_fence(__ATOMIC_RELEASE, "agent");
            asm volatile("s_waitcnt vmcnt(0)" ::: "memory");
            const unsigned og = xb_add(&bar[XB_TOP], 1u);
            const unsigned tg = og / nx;
            if (og + 1u == (tg + 1u) * nx) xb_add(&bar[XB_TOPGEN], 1u);
            else XB_SPIN(xb_ld(&bar[XB_TOPGEN]) == tg, bar);
            __builtin_amdgcn_fence(__ATOMIC_ACQUIRE, "agent");
            xb_add(&bar[XB_XGEN(b.x)], 1u);
            asm volatile("s_waitcnt vmcnt(0)" ::: "memory");
        } else {
            XB_SPIN(xb_ld(&bar[XB_XGEN(b.x)]) == gen, bar);
            __builtin_amdgcn_fence(__ATOMIC_ACQUIRE, "agent");
            asm volatile("s_waitcnt vmcnt(0)" ::: "memory");
        }
    }
    __syncthreads();
}

struct Args {
    const float* x; const float* mem; const int* pos; const float* g_emb; const float* b_emb; const float* w_in; const float* g_cq; const float* g_ckv;
    const float* w_uq; const float* w_ukv; const float* w_mem_kv; const float* g_out_a; const float* g_out_b; const float* g_out_m; const float* w_out;
    const float* g_post; const float* b_post; float* out; unsigned char* ws; int ph_lo, ph_hi;
};

__global__ void __launch_bounds__(NTHREADS, 2) fwd_mega(Args a) {
    extern __shared__ __attribute__((aligned(16))) unsigned char lds_raw[];
    LAS unsigned char* lds = (LAS unsigned char*)lds_raw;
    cg::grid_group grid = cg::this_grid();
    const int tid = threadIdx.x, lane = tid & 63, wave = __builtin_amdgcn_readfirstlane(tid >> 6);
    const int G = gridDim.x, bx = blockIdx.x;
    const int gw = bx * 8 + wave, NGW = G * 8;
    unsigned char* ws = a.ws;
    bf16_t* PROJ = (bf16_t*)(ws + WS_PROJ); bf16_t* KVB = (bf16_t*)(ws + WS_KVB); bf16_t* WIN = (bf16_t*)(ws + WS_WIN); bf16_t* WOUT = (bf16_t*)(ws + WS_WOUT);
    bf16_t* WMEM = (bf16_t*)(ws + WS_WMEM); bf16_t* WUQ = (bf16_t*)(ws + WS_WUQ); bf16_t* WUKV = (bf16_t*)(ws + WS_WUKV); bf16_t* MEMB = (bf16_t*)(ws + WS_MEMB);
    bf16_t* MKV = (bf16_t*)(ws + WS_MKV); float* ROPEA = (float*)(ws + WS_ROPEA); float* ROPEB = (float*)(ws + WS_ROPEB); float* XSTAT = (float*)(ws + WS_XSTAT);
    float* SSQQ = (float*)(ws + WS_SSQQ); float* SSQKV = (float*)(ws + WS_SSQKV); float* SSQY = (float*)(ws + WS_SSQY); float* PSTAT = (float*)(ws + WS_PSTAT);
    bf16_t* H = (bf16_t*)((unsigned char*)a.out + OUT_H); bf16_t* QB = (bf16_t*)((unsigned char*)a.out + OUT_QB);
    const int lo = a.ph_lo, hi = a.ph_hi;
    volatile LAS unsigned* xst = (volatile LAS unsigned*)(lds + LDS_BYTES - 64);
    if (tid < 2) xst[tid] = 0u;
    __syncthreads();
    const XcdBarrier xbar = xcd_barrier_post((unsigned*)(ws + WS_BAR), xst);
#ifndef PH_MASK
#define PH_MASK 63
#endif
#define IN(k) (((PH_MASK >> (k)) & 1) && lo <= (k) && (k) < hi)
#define SEAM(k) do { if (IN(k) && IN((k) + 1)) { if (lo < 0) grid.sync(); else xcd_barrier(xbar); } } while (0)
#ifndef DUP_MASK
#define DUP_MASK 0
#endif
#define REPS(k) ((((DUP_MASK) >> (k)) & 1) + 1)

    if (IN(0)) for (int rep = 0; rep < REPS(0); ++rep) { if (rep) grid.sync();
        LAS float* scr = (LAS float*)(lds + wave * 16384);
        constexpr int I_IN = (1024 / 64) * (6048 / 32), I_UQ = (256 / 64) * (768 / 32), I_UKV = (128 / 64) * (1024 / 32), I_MEM = (1024 / 64) * (1024 / 32), I_OUT = (2048 / 64) * (1024 / 32);
        constexpr int NITEMS = I_IN + I_UQ + I_UKV + I_MEM + I_OUT;
        for (int it = gw; it < NITEMS; it += NGW) {
            int r = it;
            if (r < I_IN) { tr_item<0>(a.w_in, 1024, 6048, WIN, nullptr, nullptr, nullptr, scr, r, lane); continue; } r -= I_IN;
            if (r < I_UQ) { tr_item<1>(a.w_uq, 256, 768, WUQ, a.g_cq, nullptr, nullptr, scr, r, lane); continue; } r -= I_UQ;
            if (r < I_UKV) { tr_item<2>(a.w_ukv, 128, 1024, WUKV, a.g_ckv, nullptr, nullptr, scr, r, lane); continue; } r -= I_UKV;
            if (r < I_MEM) { tr_item<3>(a.w_mem_kv, 1024, 1024, WMEM, nullptr, nullptr, nullptr, scr, r, lane); continue; } r -= I_MEM;
            tr_item<4>(a.w_out, 2048, 1024, WOUT, a.g_out_a, a.g_out_b, a.g_out_m, scr, r, lane);
        }
        for (int i = bx * NTHREADS + tid; i < 96 * 1024 / 8; i += G * NTHREADS) *(u32x4*)(WIN + (size_t)6048 * 1024 + (size_t)i * 8) = (u32x4){0u, 0u, 0u, 0u};
        {
            f32x4 gg[4], bb[4];
#pragma unroll
            for (int j = 0; j < 4; ++j) { gg[j] = *((const f32x4*)a.g_emb + lane + 64 * j); bb[j] = *((const f32x4*)a.b_emb + lane + 64 * j); }
            f32x4 nx[4];
            if (gw < T) {
#pragma unroll
                for (int j = 0; j < 4; ++j) nx[j] = *((const f32x4*)(a.x + (size_t)gw * DM) + lane + 64 * j);
            }
            for (int m = gw; m < T; m += NGW) {
                f32x4 v[4]; float s = 0.f;
#pragma unroll
                for (int j = 0; j < 4; ++j) { v[j] = nx[j]; s += (v[j][0] + v[j][1]) + (v[j][2] + v[j][3]); }
                if (m + NGW < T) {
#pragma unroll
                    for (int j = 0; j < 4; ++j) nx[j] = *((const f32x4*)(a.x + (size_t)(m + NGW) * DM) + lane + 64 * j);
                }
                const float mean = wave_sum(s) * (1.f / DM); float s2 = 0.f;
#pragma unroll
                for (int j = 0; j < 4; ++j) { v[j] = v[j] - mean; s2 += (v[j][0] * v[j][0] + v[j][1] * v[j][1]) + (v[j][2] * v[j][2] + v[j][3] * v[j][3]); }
                const float rstd = 1.0f / sqrtf(wave_sum(s2) * (1.f / DM) + EPS);
                if (lane == 0) *(f32x2*)(XSTAT + (size_t)m * 2) = (f32x2){mean, rstd};
#pragma unroll
                for (int j = 0; j < 4; ++j) {
                    const f32x4 y = v[j] * rstd * gg[j] + bb[j];
                    u32x2 o2; o2.x = cvtpk(y[0], y[1]); o2.y = cvtpk(y[2], y[3]);
                    *((u32x2*)(H + (size_t)m * DM) + lane + 64 * j) = o2;
                }
            }
        }
        for (int m = gw; m < BATCH * NMEM; m += NGW) {
#pragma unroll
            for (int j = 0; j < 4; ++j) { const f32x4 y = *((const f32x4*)(a.mem + (size_t)m * DM) + lane + 64 * j); u32x2 o2; o2.x = cvtpk(y[0], y[1]); o2.y = cvtpk(y[2], y[3]); *((u32x2*)(MEMB + (size_t)m * DM) + lane + 64 * j) = o2; }
        }
        for (int i = bx * NTHREADS + tid; i < T * 24; i += G * NTHREADS) {
            const int t = i / 24, j = i % 24;
            const double p = (double)a.pos[t];
            const double ang = p * (j < 8 ? INVF_A[j] : INVF_B[j - 8]);
            double rev = ang * 0.15915494309189535; rev = rev - floor(rev);
            const float fr = (float)rev;
            const float cs = __builtin_amdgcn_cosf(fr), sn = __builtin_amdgcn_sinf(fr);
            float* d = (j < 8) ? (ROPEA + (size_t)t * 16 + 2 * j) : (ROPEB + (size_t)t * 32 + 2 * (j - 8));
            *(f32x2*)d = (f32x2){cs, sn};
        }
    }
    SEAM(0);
#ifdef EXTRA_SYNC
    for (int e = 0; e < EXTRA_SYNC; ++e) grid.sync();
#endif

    if (IN(1)) for (int rep = 0; rep < REPS(1); ++rep) { if (rep) grid.sync();
        pg8::Gemm g{H, WIN, DM, DM, DM}; pg8::StaticOrder S; S.init(T, NP, G, bx);
        EpiProj E{PROJ, ROPEA, ROPEB, SSQQ, SSQKV};
        pg8::gemm_phase<EpiProj, false>(lds, g, S, E);
    }
    SEAM(1);

    if (IN(2)) for (int rep = 0; rep < REPS(2); ++rep) { if (rep) grid.sync();
#ifndef P2_MASK
#define P2_MASK 7
#endif
        if (P2_MASK & 1) { pg8::Gemm g{PROJ + C_CQ, WUQ, NP, 256, 256}; pg8::StaticOrder S; S.init(T, 768, G, bx); EpiQ E{QB, ROPEB, SSQQ}; pg8::gemm_phase<EpiQ, false>(lds, g, S, E); }
        if (P2_MASK & 2) { pg8::Gemm g{PROJ + C_CKV, WUKV, NP, 128, 128}; pg8::StaticOrder S; S.init(T, 1024, G, bx); EpiKV E{KVB, SSQKV}; pg8::gemm_phase<EpiKV, false>(lds, g, S, E); }
        if (P2_MASK & 4) { pg8::Gemm g{MEMB, WMEM, DM, DM, DM}; pg8::StaticOrder S; S.init(BATCH * NMEM, 1024, G, (bx + 64) % G); EpiPlain E{MKV, 1024}; pg8::gemm_phase<EpiPlain, false>(lds, g, S, E); }
    }
    SEAM(2);

    if (IN(3)) {
        constexpr int U_B = BATCH * 8 * 4, U_A = BATCH * 16 * 8, U_M = BATCH * 4 * 8;
        const bool xcdmap = (G % 8 == 0);
        auto unit_of = [&](int it_) -> int {
            if (xcdmap) { const int L = it_ * (G >> 3) + (bx >> 3), g = (L >> 3) * 8 + (bx & 7); return (g >= (U_B + U_A + U_M) / 8) ? -1 : g * 8 + (L & 7); }
            const int u_ = bx + it_ * G; return (u_ >= U_B + U_A + U_M) ? -1 : u_;
        };
        for (int it = 0;; ++it) {
            const int u = unit_of(it); if (u < 0) break;
#ifndef ATT_MASK
#define ATT_MASK 7
#endif
            if (u < U_B) { if (ATT_MASK & 1) {
                const int b = u / 32, hd = (u >> 2) & 7, qb = u & 3; const size_t r0 = (size_t)b * SEQ, rq = r0 + qb * 512;
                attn_dense_unit<96, 64, 64, 2>((LAS char*)lds, QB + rq * 768 + hd * 96, 768, KVB + r0 * 1024 + hd * 128, 1024, PROJ + r0 * NP + C_KR, NP,
                                            KVB + r0 * 1024 + hd * 128 + 64, 1024, SEQ, PROJ + rq * NP + C_BG + hd * 64, NP, SSQY + rq * 32 + 16 + hd);
            } } else if (u < U_B + U_A) { if (ATT_MASK & 2) {
                APf pf;
                { const int v = u - U_B; a_first_issue<16>(pf, PROJ + (size_t)(v / 128) * SEQ * NP + ((v >> 3) & 15) * 64, (v & 7) * 256, wave, lane); }
                for (;;) {
                    const int ucur = unit_of(it);
                    const int v = ucur - U_B, b = v / 128, hd = (v >> 3) & 15, blk = v & 7; const int P0 = blk * 256;
                    const bf16_t* prow = PROJ + (size_t)b * SEQ * NP + hd * 64;
                    float* ssqa = SSQY + (size_t)b * SEQ * 32 + hd;
                    attnA_pass<16, 0>((LAS char*)lds, prow, ssqa, P0, wave, lane, pf, [&]() { a_first_issue<4>(pf, prow, P0, wave, lane); }); __syncthreads();
                    attnA_pass<4, 1>((LAS char*)lds, prow, ssqa, P0, wave, lane, pf, [&]() { a_first_issue<1>(pf, prow, P0, wave, lane); }); __syncthreads();
                    const int u2 = unit_of(it + 1); const bool nextA = (u2 >= U_B && u2 < U_B + U_A);
                    const int v2 = u2 - U_B; const bf16_t* prow2 = PROJ + (size_t)(v2 / 128) * SEQ * NP + ((v2 >> 3) & 15) * 64; const int P02 = (v2 & 7) * 256;
                    attnA_pass<1, 2>((LAS char*)lds, prow, ssqa, P0, wave, lane, pf, [&]() { if (nextA) a_first_issue<16>(pf, prow2, P02, wave, lane); });
                    __syncthreads();
                    if (!nextA) break;
                    ++it;
                }
            } } else { if (ATT_MASK & 4) {
                const int v = u - U_B - U_A, b = v / 32, hd = (v >> 3) & 3, qb = v & 7; const size_t rq = (size_t)b * SEQ + qb * 256, rm = (size_t)b * NMEM;
                attn_dense_unit<128, 128, 128, 1>((LAS char*)lds, PROJ + rq * NP + C_MQ + hd * 128, NP, MKV + rm * 1024 + hd * 128, 1024, MKV, 1024,
                                               MKV + rm * 1024 + 512 + hd * 128, 1024, NMEM, PROJ + rq * NP + C_MG + hd * 128, NP, SSQY + rq * 32 + 24 + hd);
            } }
        }
    }
    SEAM(3);

    if (IN(4)) for (int rep = 0; rep < REPS(4); ++rep) { if (rep) grid.sync();
        pg8::Gemm g{PROJ + C_AG, WOUT, NP, 2048, 2048}; pg8::StaticOrder S; S.init(T, DM, G, bx);
        LAS f32x4* rtab = (LAS f32x4*)(lds + pg8::STAGE_BYTES);
        for (int i = 0; i < 2; ++i) { Unit u;
            if (S.next(i, u) && tid < 256) {
                const float* sp = SSQY + ((size_t)u.pm * 256 + tid) * 32;
                float sa = 0.f, sb = 0.f, sm = 0.f;
#pragma unroll
                for (int j = 0; j < 4; ++j) { const f32x4 t4 = *(const f32x4*)(sp + 4 * j); sa += (t4[0] + t4[1]) + (t4[2] + t4[3]); }
#pragma unroll
                for (int j = 4; j < 6; ++j) { const f32x4 t4 = *(const f32x4*)(sp + 4 * j); sb += (t4[0] + t4[1]) + (t4[2] + t4[3]); }
                { const f32x4 t4 = *(const f32x4*)(sp + 24); sm = (t4[0] + t4[1]) + (t4[2] + t4[3]); }
                const float ra = __builtin_amdgcn_rsqf(sa * (1.0f / 1024.0f) + EPS), rb = __builtin_amdgcn_rsqf(sb * (1.0f / 512.0f) + EPS), rm = __builtin_amdgcn_rsqf(sm * (1.0f / 512.0f) + EPS);
                rtab[i * 256 + tid] = (f32x4){ra / rb, rb / rm, rm, 0.f};
            } }
        __syncthreads();
        EpiOut E{PROJ + C_AQ, H, PSTAT, rtab};
        pg8::gemm_phase<EpiOut, true>(lds, g, S, E);
    }
    SEAM(4);

    if (IN(5)) {
        f32x4 gg[4], bb[4];
#pragma unroll
        for (int j = 0; j < 4; ++j) { gg[j] = *((const f32x4*)a.g_post + lane + 64 * j); bb[j] = *((const f32x4*)a.b_post + lane + 64 * j); }
        u32x2 npk[4]; f32x2 np = {0.f, 0.f};
        if (gw < T) {
            if (lane < 16) np = *(const f32x2*)(PSTAT + ((size_t)gw * 16 + lane) * 2);
#pragma unroll
            for (int j = 0; j < 4; ++j) npk[j] = *((const u32x2*)(PROJ + (size_t)gw * NP + C_AQ) + lane + 64 * j);
        }
        for (int m = gw; m < T; m += NGW) {
            float s = np[0], q = np[1];
            u32x2 pk[4];
#pragma unroll
            for (int j = 0; j < 4; ++j) pk[j] = npk[j];
            if (m + NGW < T) {
                np = (f32x2){0.f, 0.f};
                if (lane < 16) np = *(const f32x2*)(PSTAT + ((size_t)(m + NGW) * 16 + lane) * 2);
#pragma unroll
                for (int j = 0; j < 4; ++j) npk[j] = *((const u32x2*)(PROJ + (size_t)(m + NGW) * NP + C_AQ) + lane + 64 * j);
            }
            s = wave_sum(s); q = wave_sum(q);
            const float mean = s * (1.f / DM), var = fmaxf(q * (1.f / DM) - mean * mean, 0.f), rstd = 1.0f / sqrtf(var + EPS);
            f32x4* orow = (f32x4*)(a.out + (size_t)m * DM) + lane;
#pragma unroll
            for (int j = 0; j < 4; ++j) {
                const f32x4 v = {__builtin_bit_cast(float, pk[j].x << 16), __builtin_bit_cast(float, pk[j].x & 0xffff0000u), __builtin_bit_cast(float, pk[j].y << 16), __builtin_bit_cast(float, pk[j].y & 0xffff0000u)};
                orow[64 * j] = (v - mean) * rstd * gg[j] + bb[j];
            }
        }
    }
#undef IN
#undef SEAM
}

extern "C" void kernel_launch(void* const* d_in, const int* in_sizes, int n_in, void* d_out, int out_size, void* d_ws, size_t ws_size, hipStream_t stream) {
    static int grid_blocks = 0;
    if (grid_blocks == 0) {
        int dev = 0, cus = 0, per_cu = 0;
        hipGetDevice(&dev);
        hipDeviceGetAttribute(&cus, hipDeviceAttributeMultiprocessorCount, dev);
        hipFuncSetAttribute((const void*)fwd_mega, hipFuncAttributeMaxDynamicSharedMemorySize, LDS_BYTES);
        hipOccupancyMaxActiveBlocksPerMultiprocessor(&per_cu, (const void*)fwd_mega, NTHREADS, LDS_BYTES);
        if (per_cu < 1) { fprintf(stderr, "kernel_launch: occupancy query reports %d blocks/CU\n", per_cu); per_cu = 1; }
        if (per_cu > 1) per_cu = 1;
        grid_blocks = cus * per_cu;
        if (ws_size < WS_END) { fprintf(stderr, "kernel_launch: workspace too small (%zu < %zu)\n", ws_size, (size_t)WS_END); }
    }
    (void)hipMemsetAsync((unsigned char*)d_ws + WS_BAR, 0, XCD_BAR_WORDS * 4, stream);
    Args a{};
    a.x = (const float*)d_in[0]; a.mem = (const float*)d_in[1]; a.pos = (const int*)d_in[2]; a.g_emb = (const float*)d_in[3]; a.b_emb = (const float*)d_in[4];
    a.w_in = (const float*)d_in[5]; a.g_cq = (const float*)d_in[6]; a.g_ckv = (const float*)d_in[7]; a.w_uq = (const float*)d_in[8]; a.w_ukv = (const float*)d_in[9];
    a.w_mem_kv = (const float*)d_in[10]; a.g_out_a = (const float*)d_in[11]; a.g_out_b = (const float*)d_in[12]; a.g_out_m = (const float*)d_in[13]; a.w_out = (const float*)d_in[14];
    a.g_post = (const float*)d_in[15]; a.b_post = (const float*)d_in[16]; a.out = (float*)d_out; a.ws = (unsigned char*)d_ws; a.ph_lo = 0; a.ph_hi = 6;
    void* args[] = {&a};
    hipError_t e = hipLaunchCooperativeKernel((const void*)fwd_mega, dim3(grid_blocks), dim3(NTHREADS), args, LDS_BYTES, stream);
    if (e != hipSuccess) fprintf(stderr, "cooperative launch failed: %s (grid %d)\n", hipGetErrorString(e), grid_blocks);
}
```

```cpp
#include <hip/hip_runtime.h>
#include <hip/hip_cooperative_groups.h>
#include <cstdio>
#include <cstdint>
namespace cg = cooperative_groups;

#define LAS __attribute__((address_space(3)))
#define DI __device__ __forceinline__
typedef unsigned short bf16_t;
typedef short bf16x8 __attribute__((ext_vector_type(8)));
typedef short s16x4 __attribute__((ext_vector_type(4)));
typedef float f32x4 __attribute__((ext_vector_type(4)));
typedef float f32x2 __attribute__((ext_vector_type(2)));
typedef float f32x16 __attribute__((ext_vector_type(16)));
typedef unsigned u32x4 __attribute__((ext_vector_type(4)));
typedef unsigned u32x2 __attribute__((ext_vector_type(2)));
typedef __bf16 bf16x2_t __attribute__((ext_vector_type(2)));

constexpr int BATCH = 16, SEQ = 2048, DM = 1024, T = BATCH * SEQ, NMEM = 256;
constexpr int N1 = 6144;
constexpr int NP = 3072, WOFF = 3072;
constexpr int C_AG = 0, C_BG = 1024, C_MG = 1536, C_MQ = 2048, C_CQ = 2560, C_CKV = 2816, C_KR = 2944;
constexpr float EPS = 1e-5f;
constexpr float LOG2E = 1.4426950408889634f;
constexpr float ALPHA = 1.189207115002721f;
constexpr float NEGBIG = -1e30f;

constexpr size_t MiB = 1u << 20;
constexpr size_t WS_PROJ = 0, WS_QH = 192 * MiB  , WS_KVB = 384 * MiB, WS_WIN = 448 * MiB, WS_WOUT = 460 * MiB, WS_WMEM = 464 * MiB, WS_WUQ = 466 * MiB, WS_WUKV = 467 * MiB,
                 WS_MEMB = 468 * MiB, WS_MKV = 476 * MiB, WS_ROPEA = 484 * MiB, WS_ROPEB = 486 * MiB, WS_XSTAT = 490 * MiB, WS_SSQQ = 491 * MiB, WS_SSQKV = 492 * MiB,
                 WS_SSQY = 493 * MiB, WS_PSTAT = 497 * MiB, WS_BAR = 501 * MiB, WS_KR = 502 * MiB  , WS_END = 504 * MiB;
constexpr size_t OUT_H = 0, OUT_QB = 64 * MiB;

constexpr int LDS_BYTES = 155648;
constexpr int NTHREADS = 512;

DI unsigned cvtpk(float lo, float hi) { f32x2 v = {lo, hi}; bf16x2_t b = __builtin_convertvector(v, bf16x2_t); return __builtin_bit_cast(unsigned, b); }
DI float bf2f(unsigned short u) { return __builtin_bit_cast(float, (unsigned)u << 16); }
DI float wave_sum(float v) {
#pragma unroll
    for (int o = 1; o < 64; o <<= 1) v += __shfl_xor(v, o);
    return v;
}
DI float fast_exp2(float x) { return __builtin_amdgcn_exp2f(x); }
DI float silu(float g) { return g * __builtin_amdgcn_rcpf(1.0f + fast_exp2(-g * LOG2E)); }

namespace pg8 {
constexpr int BM = 256, BK = 64, HALF = 128, HTB = HALF * BK * 2, STAGE_BYTES = 8 * HTB, NXCD = 8, WGM = 8;
__host__ __device__ __forceinline__ int lds_byte(int r, int c) { const int st = (r >> 4) * 2 + (c >> 5), rr = r & 15, cc = c & 31, ob = rr * 64 + cc * 2; return st * 1024 + (ob ^ (((ob >> 9) & 1) << 5)); }
__host__ __device__ __forceinline__ void stage_rc(int b, int& R, int& C) { const int st = b / 1024, sb = b % 1024, swz = sb ^ (((sb >> 9) & 1) << 5); R = (st >> 1) * 16 + swz / 64; C = (st & 1) * 32 + (swz % 64) / 2; }
__host__ __device__ __forceinline__ int perm32(int rho) { const int n = rho >> 4, i = rho & 15; return 8 * (i >> 2) + 4 * n + (i & 3); }

struct Unit { int pm, pn; };
struct Gemm { const bf16_t* A; const bf16_t* Bt; int lda, ldb, K; };

struct StaticOrder {
    int nM, nN, nwg, G, c, base, limit;
    __device__ void init(int M, int N, int G_, int c_) { nM = M / BM; nN = N / BM; nwg = nM * nN; G = G_; c = c_; base = 0; limit = nwg; }
    __device__ void window(int base_, int limit_) { base = base_; limit = limit_; }
    __device__ bool next(int i, Unit& u) const {
        const long L = (long)base + (long)i * G + c; if (c < 0 || L >= limit) return false;
        int wgid = (int)L; { const int q = nwg / NXCD, r = nwg % NXCD, xcd = wgid % NXCD, off = wgid / NXCD; wgid = (xcd < r ? xcd * (q + 1) : r * (q + 1) + (xcd - r) * q) + off; }
        const int nig = WGM * nN, gid = wgid / nig, fm = gid * WGM, gsz = (nM - fm) < WGM ? (nM - fm) : WGM;
        u.pm = fm + ((wgid % nig) % gsz); u.pn = (wgid % nig) / gsz; return true;
    }
};

template <class Epi, bool HOOK>
DI void gemm_phase(LAS unsigned char* lds, const Gemm g, const StaticOrder& S, const Epi& E) {
    int tid_ = threadIdx.x; asm volatile("" : "+v"(tid_));
    const int tid = tid_, wid = __builtin_amdgcn_readfirstlane(tid >> 6), lane = tid & 63, wr = wid >> 2, wc = wid & 3, fr = lane & 15, fq = lane >> 4;
    const int K = g.K, nt = K / BK;
    unsigned voffA[2], voffB[2];
#pragma unroll
    for (int i = 0; i < 2; ++i) { int R, C; stage_rc(tid * 16 + i * 8192, R, C); const int Rb = (R & ~31) + perm32(R & 31);
        voffA[i] = (unsigned)(R * g.lda + C) * 2u; voffB[i] = (unsigned)(Rb * g.ldb + C) * 2u; }
    const size_t kstep = (size_t)(BK * 2);
    const size_t hstepA = (size_t)HALF * g.lda * 2, hstepB = (size_t)HALF * g.ldb * 2;
    const size_t tstepA = 2 * hstepA, tstepB = 2 * hstepB;
    const unsigned ldsw = (unsigned)wid * 1024u;
    const int aoff = lds_byte(wr * 64 + fr, fq * 8), boff = lds_byte(wc * 32 + fr, fq * 8);
#define PG8_SA(b, h) (((b) * 2 + (h)) * HTB)
#define PG8_SB(b, h) ((4 + (b) * 2 + (h)) * HTB)
#define PG8_STAGE(bufoff, gbase, voff) do { _Pragma("unroll") for (int _i = 0; _i < 2; ++_i) \
        __builtin_amdgcn_global_load_lds((const unsigned*)((const char*)(gbase) + (voff)[_i]), (LAS unsigned*)(lds + (bufoff) + ldsw + _i * 8192), 16, 0, 0); } while (0)
#define PG8_LDA(dst, b, h) do { _Pragma("unroll") for (int m = 0; m < 4; ++m) _Pragma("unroll") for (int k = 0; k < 2; ++k) dst[m][k] = *(const LAS bf16x8*)(lds + PG8_SA(b, h) + aoff + m * 2048 + k * 1024); } while (0)
#define PG8_LDB(dst, b, h) do { _Pragma("unroll") for (int n = 0; n < 2; ++n) _Pragma("unroll") for (int k = 0; k < 2; ++k) dst[n][k] = *(const LAS bf16x8*)(lds + PG8_SB(b, h) + boff + n * 2048 + k * 1024); } while (0)
#define PG8_MMA(ai, bj, At, Bt) do { __builtin_amdgcn_s_setprio(1); _Pragma("unroll") for (int m = 0; m < 4; ++m) _Pragma("unroll") for (int n = 0; n < 2; ++n) _Pragma("unroll") for (int k = 0; k < 2; ++k) \
        acc[ai][bj][m][n] = __builtin_amdgcn_mfma_f32_16x16x32_bf16(Bt[n][k], At[m][k], acc[ai][bj][m][n], 0, 0, 0); __builtin_amdgcn_s_setprio(0); } while (0)
#define PG8_WAIT_V(n) asm volatile("s_waitcnt vmcnt(" #n ")" ::: "memory")
#define PG8_WAIT_L(n) asm volatile("s_waitcnt lgkmcnt(" #n ")" ::: "memory")
#define PG8_BAR __builtin_amdgcn_s_barrier()
#define PG8_SCHED __builtin_amdgcn_sched_barrier(0)
    Unit cur, nxt; int ui = 0;
    if (!S.next(0, cur)) return;
    f32x4 acc[2][2][4][2];
#pragma unroll
    for (int a = 0; a < 2; ++a)
#pragma unroll
        for (int b = 0; b < 2; ++b)
#pragma unroll
            for (int m = 0; m < 4; ++m)
#pragma unroll
                for (int n = 0; n < 2; ++n) acc[a][b][m][n] = (f32x4){0.f, 0.f, 0.f, 0.f};
    bf16x8 At[4][2], B0[2][2], B1[2][2];
    const char* cA = (const char*)g.A + (size_t)cur.pm * tstepA; const char* cB = (const char*)g.Bt + (size_t)cur.pn * tstepB;
    PG8_STAGE(PG8_SB(0, 0), cB, voffB); PG8_STAGE(PG8_SB(0, 1), cB + hstepB, voffB); PG8_STAGE(PG8_SA(0, 0), cA, voffA); PG8_STAGE(PG8_SA(0, 1), cA + hstepA, voffA);
    if (wr == 1) PG8_BAR;
    PG8_WAIT_V(2); PG8_BAR;
    PG8_STAGE(PG8_SB(1, 0), cB + kstep, voffB); PG8_STAGE(PG8_SA(1, 0), cA + kstep, voffA); PG8_STAGE(PG8_SB(1, 1), cB + hstepB + kstep, voffB);
    PG8_WAIT_V(6); PG8_BAR;
    for (;;) {
        const bool has_next = S.next(ui + 1, nxt);
        const char* nA = has_next ? (const char*)g.A + (size_t)nxt.pm * tstepA : cA; const char* nB = has_next ? (const char*)g.Bt + (size_t)nxt.pn * tstepB : cB;
#pragma unroll 1
        for (int t = 0; t < nt; t += 2) {
            const bool last = (t == nt - 2);
            const char* a1 = cA + (size_t)(t + 1) * kstep;
            const char* a2 = last ? nA : cA + (size_t)(t + 2) * kstep; const char* b2 = last ? nB : cB + (size_t)(t + 2) * kstep;
            const char* a3 = a2 + kstep; const char* b3 = b2 + kstep;
            if constexpr (HOOK) { if (t == 16 || t == 24) E.hook(acc, ui, t, wr, fr); }
            PG8_LDB(B0, 0, 0); PG8_LDB(B1, 0, 1); PG8_SCHED; PG8_LDA(At, 0, 0); PG8_STAGE(PG8_SA(1, 1), a1 + hstepA, voffA);
            PG8_WAIT_V(8); PG8_WAIT_L(0); PG8_BAR; PG8_MMA(0, 0, At, B0); PG8_MMA(0, 1, At, B1); PG8_BAR; PG8_SCHED;
            PG8_LDA(At, 0, 1); PG8_STAGE(PG8_SB(0, 0), b2, voffB); PG8_STAGE(PG8_SB(0, 1), b2 + hstepB, voffB); PG8_STAGE(PG8_SA(0, 0), a2, voffA);
            PG8_WAIT_V(8); PG8_WAIT_L(0); PG8_BAR; PG8_MMA(1, 0, At, B0); PG8_MMA(1, 1, At, B1); PG8_BAR; PG8_SCHED;
            PG8_LDB(B0, 1, 0); PG8_LDB(B1, 1, 1); PG8_SCHED; PG8_LDA(At, 1, 0); PG8_STAGE(PG8_SA(0, 1), a2 + hstepA, voffA);
            PG8_WAIT_V(8); PG8_WAIT_L(0); PG8_BAR; PG8_MMA(0, 0, At, B0); PG8_MMA(0, 1, At, B1); PG8_BAR; PG8_SCHED;
            PG8_LDA(At, 1, 1); PG8_STAGE(PG8_SB(1, 0), b3, voffB); PG8_STAGE(PG8_SB(1, 1), b3 + hstepB, voffB); PG8_STAGE(PG8_SA(1, 0), a3, voffA);
            PG8_WAIT_V(8); PG8_WAIT_L(0); PG8_BAR; PG8_MMA(1, 0, At, B0); PG8_MMA(1, 1, At, B1); PG8_BAR; PG8_SCHED;
        }
        if (wr == 0) PG8_BAR;
        E(acc, cur, ui, wr, wc, fr, fq);
        if (!has_next) break;
#pragma unroll
        for (int a = 0; a < 2; ++a)
#pragma unroll
            for (int b = 0; b < 2; ++b)
#pragma unroll
                for (int m = 0; m < 4; ++m)
#pragma unroll
                    for (int n = 0; n < 2; ++n) acc[a][b][m][n] = (f32x4){0.f, 0.f, 0.f, 0.f};
        cur = nxt; cA = nA; cB = nB; ++ui;
        if (wr == 1) PG8_BAR;
    }
    PG8_WAIT_V(0);
    PG8_BAR;
#undef PG8_SA
#undef PG8_SB
#undef PG8_STAGE
#undef PG8_LDA
#undef PG8_LDB
#undef PG8_MMA
#undef PG8_WAIT_V
#undef PG8_WAIT_L
#undef PG8_BAR
#undef PG8_SCHED
}
}
using pg8::Unit;

DI void rope4(f32x4& v0, f32x4& v1, const f32x4 cs0, const f32x4 cs1) {
    f32x4 a = v0, b = v1;
    v0[0] = a[0] * cs0[0] - a[1] * cs0[1]; v0[1] = a[1] * cs0[0] + a[0] * cs0[1];
    v0[2] = a[2] * cs0[2] - a[3] * cs0[3]; v0[3] = a[3] * cs0[2] + a[2] * cs0[3];
    v1[0] = b[0] * cs1[0] - b[1] * cs1[1]; v1[1] = b[1] * cs1[0] + b[0] * cs1[1];
    v1[2] = b[2] * cs1[2] - b[3] * cs1[3]; v1[3] = b[3] * cs1[2] + b[2] * cs1[3];
}
DI void store8(bf16_t* p, const f32x4 v0, const f32x4 v1) {
    u32x4 w; w.x = cvtpk(v0[0], v0[1]); w.y = cvtpk(v0[2], v0[3]); w.z = cvtpk(v1[0], v1[1]); w.w = cvtpk(v1[2], v1[3]);
    *(u32x4*)p = w;
}

struct EpiProj {
    bf16_t* O; bf16_t* QH; bf16_t* KR; const float* ropeA; const float* ropeB; float* ssqq; float* ssqkv;
    DI void hook(f32x4 (&)[2][2][4][2], int, int, int, int) const {}
    DI void operator()(const f32x4 (&acc)[2][2][4][2], const Unit& u, int ui, int wr, int wc, int fr, int fq) const {
        const int row0 = u.pm * 256 + wr * 64 + fr, col0 = u.pn * 256 + wc * 32 + 8 * fq;
        const bool rA = (u.pn < 8) && ((wc & 1) == 0) && (fq < 2);
        const bool rB = (u.pn == 23) && (wc == 0);
        const bool sq = (u.pn >= 22);
#pragma unroll
        for (int ai = 0; ai < 2; ++ai)
#pragma unroll
            for (int m = 0; m < 4; ++m) {
                const int row = row0 + ai * 128 + m * 16;
                f32x4 ca0, ca1, cb0, cb1;
                if (rA) { ca0 = *(const f32x4*)(ropeA + (size_t)row * 16 + 8 * fq); ca1 = *(const f32x4*)(ropeA + (size_t)row * 16 + 8 * fq + 4); }
                if (rB) { cb0 = *(const f32x4*)(ropeB + (size_t)row * 32 + 8 * fq); cb1 = *(const f32x4*)(ropeB + (size_t)row * 32 + 8 * fq + 4); }
                float s0 = 0.f, s1 = 0.f;
#pragma unroll
                for (int bj = 0; bj < 2; ++bj) {
                    f32x4 v0 = acc[ai][bj][m][0], v1 = acc[ai][bj][m][1];
                    const float q = (v0[0] * v0[0] + v0[1] * v0[1]) + (v0[2] * v0[2] + v0[3] * v0[3]) + (v1[0] * v1[0] + v1[1] * v1[1]) + (v1[2] * v1[2] + v1[3] * v1[3]);
                    if (bj == 0) s0 = q; else s1 = q;
                    if (rA) rope4(v0, v1, ca0, ca1);
                    if (rB && bj == 1) rope4(v0, v1, cb0, cb1);
                    if (u.pn < 12) {
                        const int head = (u.pn & 3) * 4 + bj * 2 + (wc >> 1), dim = (wc & 1) * 32 + 8 * fq, bb = row / SEQ, ss = row - bb * SEQ;
                        store8(QH + (size_t)(u.pn >> 2) * ((size_t)T * 1024) + ((size_t)(bb * 16 + head) * SEQ + ss) * 64 + dim, v0, v1);
                    } else if (rB && bj == 1) store8(KR + (size_t)row * 32 + 8 * fq, v0, v1);
                    else store8(O + (size_t)row * NP + (col0 - WOFF) + bj * 128, v0, v1);
                }
                if (sq) {
                    float s = (u.pn == 22) ? (s0 + s1) : s0;
                    s += __shfl_xor(s, 16); s += __shfl_xor(s, 32);
                    if (fq == 0) { float* d = (u.pn == 22) ? ssqq : ssqkv; d[(size_t)row * 4 + wc] = s; }
                }
            }
    }
};
struct EpiQ {
    bf16_t* O; const float* ropeB; const float* ssqq;
    DI void hook(f32x4 (&)[2][2][4][2], int, int, int, int) const {}
    DI void operator()(const f32x4 (&acc)[2][2][4][2], const Unit& u, int ui, int wr, int wc, int fr, int fq) const {
        const int row0 = u.pm * 256 + wr * 64 + fr, col0 = u.pn * 256 + wc * 32 + 8 * fq;
#pragma unroll
        for (int ai = 0; ai < 2; ++ai)
#pragma unroll
            for (int m = 0; m < 4; ++m) {
                const int row = row0 + ai * 128 + m * 16;
                const f32x4 sq = *(const f32x4*)(ssqq + (size_t)row * 4);
                const float rs = __builtin_amdgcn_rsqf(((sq[0] + sq[1]) + (sq[2] + sq[3])) * (1.0f / 256.0f) + EPS);
#pragma unroll
                for (int bj = 0; bj < 2; ++bj) {
                    f32x4 v0 = acc[ai][bj][m][0] * rs, v1 = acc[ai][bj][m][1] * rs;
                    const int cg0 = u.pn * 256 + bj * 128 + wc * 32;
                    if ((cg0 % 96) == 64) { const f32x4 cb0 = *(const f32x4*)(ropeB + (size_t)row * 32 + 8 * fq), cb1 = *(const f32x4*)(ropeB + (size_t)row * 32 + 8 * fq + 4); rope4(v0, v1, cb0, cb1); }
                    store8(O + (size_t)row * 768 + col0 + bj * 128, v0, v1);
                }
                asm volatile("" ::: "memory");
            }
    }
};
struct EpiKV {
    bf16_t* O; const float* ssqkv;
    DI void hook(f32x4 (&)[2][2][4][2], int, int, int, int) const {}
    DI void operator()(const f32x4 (&acc)[2][2][4][2], const Unit& u, int ui, int wr, int wc, int fr, int fq) const {
        const int row0 = u.pm * 256 + wr * 64 + fr, col0 = u.pn * 256 + wc * 32 + 8 * fq;
#pragma unroll
        for (int ai = 0; ai < 2; ++ai)
#pragma unroll
            for (int m = 0; m < 4; ++m) {
                const int row = row0 + ai * 128 + m * 16;
                const f32x4 sq = *(const f32x4*)(ssqkv + (size_t)row * 4);
                const float rs = __builtin_amdgcn_rsqf(((sq[0] + sq[1]) + (sq[2] + sq[3])) * (1.0f / 128.0f) + EPS);
                const int bb = row / SEQ, ss = row - bb * SEQ;
#pragma unroll
                for (int bj = 0; bj < 2; ++bj) store8(O + ((size_t)(bb * 8 + 2 * u.pn + bj) * SEQ + ss) * 128 + wc * 32 + 8 * fq, acc[ai][bj][m][0] * rs, acc[ai][bj][m][1] * rs);
                asm volatile("" ::: "memory");
            }
    }
};
struct EpiPlain {
    bf16_t* O; int ldc;
    DI void hook(f32x4 (&)[2][2][4][2], int, int, int, int) const {}
    DI void operator()(const f32x4 (&acc)[2][2][4][2], const Unit& u, int ui, int wr, int wc, int fr, int fq) const {
        const int row0 = u.pm * 256 + wr * 64 + fr, col0 = u.pn * 256 + wc * 32 + 8 * fq;
#pragma unroll
        for (int ai = 0; ai < 2; ++ai)
#pragma unroll
            for (int m = 0; m < 4; ++m) {
                const int row = row0 + ai * 128 + m * 16;
#pragma unroll
                for (int bj = 0; bj < 2; ++bj) store8(O + (size_t)row * ldc + col0 + bj * 128, acc[ai][bj][m][0], acc[ai][bj][m][1]);
            }
    }
};
struct EpiOut {
    bf16_t* stage; const bf16_t* hb; float* pstat;
    const LAS f32x4* rtab;
    DI void hook(f32x4 (&acc)[2][2][4][2], int ui, int t, int wr, int fr) const {
#pragma unroll
        for (int ai = 0; ai < 2; ++ai)
#pragma unroll
            for (int m = 0; m < 4; ++m) {
                const f32x4 r = rtab[ui * 256 + ai * 128 + wr * 64 + m * 16 + fr];
                const float f = (t == 16) ? r[0] : r[1];
#pragma unroll
                for (int bj = 0; bj < 2; ++bj) { acc[ai][bj][m][0] = acc[ai][bj][m][0] * f; acc[ai][bj][m][1] = acc[ai][bj][m][1] * f; }
            }
    }
    DI void operator()(const f32x4 (&acc)[2][2][4][2], const Unit& u, int ui, int wr, int wc, int fr, int fq) const {
        const int col0 = u.pn * 256 + wc * 32 + 8 * fq;
#pragma unroll
        for (int ai = 0; ai < 2; ++ai)
#pragma unroll
            for (int m = 0; m < 4; ++m) {
                const int rl = ai * 128 + wr * 64 + m * 16 + fr, row = u.pm * 256 + rl;
                const float rsm = rtab[ui * 256 + rl][2];
                float s = 0.f, q = 0.f;
#pragma unroll
                for (int bj = 0; bj < 2; ++bj) {
                    const u32x4 hw = *(const u32x4*)(hb + (size_t)row * DM + col0 + bj * 128);
                    const f32x4 h0 = {__builtin_bit_cast(float, hw.x << 16), __builtin_bit_cast(float, hw.x & 0xffff0000u), __builtin_bit_cast(float, hw.y << 16), __builtin_bit_cast(float, hw.y & 0xffff0000u)};
                    const f32x4 h1 = {__builtin_bit_cast(float, hw.z << 16), __builtin_bit_cast(float, hw.z & 0xffff0000u), __builtin_bit_cast(float, hw.w << 16), __builtin_bit_cast(float, hw.w & 0xffff0000u)};
                    const f32x4 v0 = acc[ai][bj][m][0] * rsm + h0 * ALPHA, v1 = acc[ai][bj][m][1] * rsm + h1 * ALPHA;
                    store8(stage + (size_t)row * DM + col0 + bj * 128, v0, v1);
                    s += ((v0[0] + v0[1]) + (v0[2] + v0[3])) + ((v1[0] + v1[1]) + (v1[2] + v1[3]));
                    q += ((v0[0] * v0[0] + v0[1] * v0[1]) + (v0[2] * v0[2] + v0[3] * v0[3])) + ((v1[0] * v1[0] + v1[1] * v1[1]) + (v1[2] * v1[2] + v1[3] * v1[3]));
                }
                s += __shfl_xor(s, 16); s += __shfl_xor(s, 32); q += __shfl_xor(q, 16); q += __shfl_xor(q, 32);
                if (fq == 0) *(f32x2*)(pstat + ((size_t)row * 16 + u.pn * 4 + wc) * 2) = (f32x2){s, q};
            }
    }
};

DI float xhalf_max(float x) { float a = x, b = x; asm volatile("s_nop 1\n\tv_permlane32_swap_b32 %0, %1" : "+v"(a), "+v"(b)); return fmaxf(a, b); }
#define MFMA32(a, b, c) __builtin_amdgcn_mfma_f32_32x32x16_bf16((a), (b), (c), 0, 0, 0)
DI int crow(int reg, int h) { return (reg & 3) + 8 * (reg >> 2) + 4 * h; }
DI s16x4 vtr(const LAS char* p) { return __builtin_bit_cast(s16x4, __builtin_amdgcn_ds_read_tr16_b64_v4i16((LAS s16x4*)p)); }
DI bf16x8 pack8(const f32x16& x, int s) {
    u32x4 p; p.x = cvtpk(x[8 * s], x[8 * s + 1]); p.y = cvtpk(x[8 * s + 2], x[8 * s + 3]); p.z = cvtpk(x[8 * s + 4], x[8 * s + 5]); p.w = cvtpk(x[8 * s + 6], x[8 * s + 7]);
    return __builtin_bit_cast(bf16x8, p);
}
DI float max16(const f32x16& s) {
    float a = fmaxf(fmaxf(s[0], s[1]), fmaxf(s[2], s[3])), b = fmaxf(fmaxf(s[4], s[5]), fmaxf(s[6], s[7]));
    float c = fmaxf(fmaxf(s[8], s[9]), fmaxf(s[10], s[11])), d = fmaxf(fmaxf(s[12], s[13]), fmaxf(s[14], s[15]));
    return fmaxf(fmaxf(a, b), fmaxf(c, d));
}


template <int DV>
DI void epi_rows(LAS float* buf, const f32x16* o, float inv, bf16_t* gy0  , int gp, float* ssq0, int lane) {
    constexpr int P = DV + 4, CH = DV / 8, RPI = 64 / CH, NIT = 32 / RPI;
    const int r32 = lane & 31, h = lane >> 5;
#pragma unroll
    for (int d = 0; d < DV / 32; ++d)
#pragma unroll
        for (int g = 0; g < 4; ++g) *(LAS f32x4*)(buf + r32 * P + 32 * d + 8 * g + 4 * h) = (f32x4){o[d][4 * g] * inv, o[d][4 * g + 1] * inv, o[d][4 * g + 2] * inv, o[d][4 * g + 3] * inv};
    asm volatile("" ::: "memory");
    const int c = lane % CH, q0 = lane / CH;
#pragma unroll
    for (int i = 0; i < NIT; ++i) {
        const int q = q0 + RPI * i;
        const f32x4 a0 = *(const LAS f32x4*)(buf + q * P + 8 * c), a1 = *(const LAS f32x4*)(buf + q * P + 8 * c + 4);
        bf16_t* gy = gy0 + (size_t)q * gp + 8 * c;
        const u32x4 gw = *(const u32x4*)gy;
        float sq = (a0[0] * a0[0] + a0[1] * a0[1]) + (a0[2] * a0[2] + a0[3] * a0[3]) + (a1[0] * a1[0] + a1[1] * a1[1]) + (a1[2] * a1[2] + a1[3] * a1[3]);
#pragma unroll
        for (int m = 1; m < CH; m <<= 1) sq += __shfl_xor(sq, m);
        u32x4 ow;
        ow.x = cvtpk(a0[0] * silu(__builtin_bit_cast(float, gw.x << 16)), a0[1] * silu(__builtin_bit_cast(float, gw.x & 0xffff0000u)));
        ow.y = cvtpk(a0[2] * silu(__builtin_bit_cast(float, gw.y << 16)), a0[3] * silu(__builtin_bit_cast(float, gw.y & 0xffff0000u)));
        ow.z = cvtpk(a1[0] * silu(__builtin_bit_cast(float, gw.z << 16)), a1[1] * silu(__builtin_bit_cast(float, gw.z & 0xffff0000u)));
        ow.w = cvtpk(a1[2] * silu(__builtin_bit_cast(float, gw.w << 16)), a1[3] * silu(__builtin_bit_cast(float, gw.w & 0xffff0000u)));
        *(u32x4*)gy = ow;
        if (c == 0) ssq0[(size_t)q * 32] = sq;
    }
    asm volatile("" ::: "memory");
}

template <int DQK, int D1, int DV, int QT>
DI void attn_dense_unit(LAS char* lds, const bf16_t* q, int qp, const bf16_t* k1, int k1p, const bf16_t* k2, int k2p, const bf16_t* v, int vp, int nkeys,
                        bf16_t* gate_y, int gp, float* ssq  ) {
    constexpr int KP = DQK * 2 + 16, VP = DV * 2 + (DV == 64 ? 16 : 32);
    constexpr int KT = 64 * KP, VT = 64 * VP, BUF = KT + VT;
    constexpr int KCH = DQK / 8, VCH = DV / 8, NKC = 64 * KCH, NVC = 64 * VCH;
    constexpr int KI = (NKC + NTHREADS - 1) / NTHREADS, VI = (NVC + NTHREADS - 1) / NTHREADS;
    constexpr int NKS = DQK / 16, NDT = DV / 32;
    int tid_ = threadIdx.x; asm volatile("" : "+v"(tid_));
    const int tid = tid_, lane = tid & 63, w = __builtin_amdgcn_readfirstlane(tid >> 6), r32 = lane & 31, h = lane >> 5;
    bf16x8 qf[QT][NKS];
#pragma unroll
    for (int qt = 0; qt < QT; ++qt) { const bf16_t* qr = q + (size_t)((w * QT + qt) * 32 + r32) * qp + 8 * h;
#pragma unroll
      for (int s = 0; s < NKS; ++s) qf[qt][s] = *(const bf16x8*)(qr + 16 * s); }
    u32x4 kreg[KI], vreg[VI];
    auto load_regs = [&](int t) {
#pragma unroll
        for (int i = 0; i < KI; ++i) { const int c = tid + i * NTHREADS; if (NKC % NTHREADS == 0 || c < NKC) { const int r = c / KCH, j = c % KCH; const size_t row = (size_t)(t * 64 + r);
            kreg[i] = (j * 8 < D1) ? *(const u32x4*)(k1 + row * k1p + j * 8) : *(const u32x4*)(k2 + row * k2p + (j * 8 - D1)); } }
#pragma unroll
        for (int i = 0; i < VI; ++i) { const int c = tid + i * NTHREADS; if (NVC % NTHREADS == 0 || c < NVC) { const int r = c / VCH, j = c % VCH; vreg[i] = *(const u32x4*)(v + (size_t)(t * 64 + r) * vp + j * 8); } }
    };
    auto store_lds = [&](int b) {
        LAS char* kb = lds + b * BUF; LAS char* vb = kb + KT;
#pragma unroll
        for (int i = 0; i < KI; ++i) { const int c = tid + i * NTHREADS; if (NKC % NTHREADS == 0 || c < NKC) { const int r = c / KCH, j = c % KCH; *(LAS u32x4*)(kb + r * KP + j * 16) = kreg[i]; } }
#pragma unroll
        for (int i = 0; i < VI; ++i) { const int c = tid + i * NTHREADS; if (NVC % NTHREADS == 0 || c < NVC) { const int r = c / VCH, j = c % VCH; *(LAS u32x4*)(vb + r * VP + j * 16) = vreg[i]; } }
    };
    f32x16 o[QT][NDT]; float mrun[QT], lrun[QT];
#pragma unroll
    for (int qt = 0; qt < QT; ++qt) { mrun[qt] = NEGBIG; lrun[qt] = 0.f;
#pragma unroll
        for (int d = 0; d < NDT; ++d)
#pragma unroll
            for (int i = 0; i < 16; ++i) o[qt][d][i] = 0.f; }
    const int i16 = lane & 15, tq = i16 >> 2, tp = i16 & 3, blk = (lane >> 4) & 1;
    const int voff = (4 * h + tq) * VP + (16 * blk + 4 * tp) * 2;
    const int NT = nkeys / 64;
    load_regs(0); store_lds(0);
#pragma unroll
    for (int qt = 0; qt < QT; ++qt)
#pragma unroll
        for (int s = 0; s < NKS; ++s) asm volatile("" : "+v"(qf[qt][s]));
    __syncthreads();
    for (int t = 0; t < NT; ++t) {
        if (t + 1 < NT) load_regs(t + 1);
        const LAS char* kb = lds + (t & 1) * BUF; const LAS char* vb = kb + KT;
#pragma unroll
        for (int sub = 0; sub < 2; ++sub) {
            f32x16 sc[QT];
#pragma unroll
            for (int qt = 0; qt < QT; ++qt)
#pragma unroll
                for (int i = 0; i < 16; ++i) sc[qt][i] = 0.f;
            __builtin_amdgcn_s_setprio(1);
#pragma unroll
            for (int s = 0; s < NKS; ++s) {
                const bf16x8 a0 = *(const LAS bf16x8*)(kb + (32 * sub + r32) * KP + (16 * s + 8 * h) * 2);
#pragma unroll
                for (int qt = 0; qt < QT; ++qt) sc[qt] = MFMA32(a0, qf[qt][s], sc[qt]);
            }
            __builtin_amdgcn_s_setprio(0);
            bf16x8 pb[QT][2];
#pragma unroll
            for (int qt = 0; qt < QT; ++qt) {
                float mx = max16(sc[qt]); mx = xhalf_max(mx);
                const float mnew = fmaxf(mrun[qt], mx);
                if (__builtin_amdgcn_ballot_w64(mnew > mrun[qt]) != 0ull) {
                    const float alpha = fast_exp2(mrun[qt] - mnew); lrun[qt] = lrun[qt] * alpha;
#pragma unroll
                    for (int d = 0; d < NDT; ++d) o[qt][d] = o[qt][d] * alpha;
                }
                mrun[qt] = mnew;
                float rs = 0.f;
#pragma unroll
                for (int i = 0; i < 16; ++i) { sc[qt][i] = fast_exp2(sc[qt][i] - mnew); rs += sc[qt][i]; }
                lrun[qt] = lrun[qt] + rs;
                pb[qt][0] = pack8(sc[qt], 0); pb[qt][1] = pack8(sc[qt], 1);
            }
#pragma unroll
            for (int ks = 0; ks < 2; ++ks) {
                const LAS char* vr = vb + voff + (32 * sub + 16 * ks) * VP;
#pragma unroll
                for (int d = 0; d < NDT; ++d) {
                    const s16x4 lo = vtr(vr + d * 64), hi = vtr(vr + 8 * VP + d * 64);
                    const bf16x8 va = __builtin_shufflevector(lo, hi, 0, 1, 2, 3, 4, 5, 6, 7);
#pragma unroll
                    for (int qt = 0; qt < QT; ++qt) o[qt][d] = MFMA32(va, pb[qt][ks], o[qt][d]);
                }
            }
        }
        if (t + 1 < NT) store_lds((t + 1) & 1);
        __syncthreads();
    }
#pragma unroll
    for (int qt = 0; qt < QT; ++qt) {
        const float ltot = lrun[qt] + __shfl_xor(lrun[qt], 32), inv = 1.0f / ltot;
        const int row0 = (w * QT + qt) * 32;
        epi_rows<DV>((LAS float*)(lds + w * (32 * (DV + 4) * 4)), o[qt], inv, gate_y + (size_t)row0 * gp, gp, ssq + (size_t)row0 * 32, lane);
    }
    __syncthreads();
}

constexpr int A_OSTP = 64;
DI int a_swz(int row, int chunk) { return ((chunk ^ row ^ (row >> 4)) & 15) * 4; }
constexpr int A_ML_OFF = 256 * A_OSTP * 4, A_VW_OFF = A_ML_OFF + 2048, A_VP = 144, A_VWB = 2 * 32 * A_VP;
struct AHead { const bf16_t* q; const bf16_t* k; const bf16_t* v; bf16_t* gate; };
struct APf { u32x4 kc[4], vc[4]; bf16x8 qf[4]; };
template <int DIL> DI void a_geom(int P0, int w, int r32, int& qpos, int& kb0) {
    if (DIL == 16) { const int cls = w + 8 * (r32 >> 4); qpos = P0 + cls + 16 * (r32 & 15); kb0 = 0; }
    else if (DIL == 4) { const int base = P0 + 128 * (w >> 2) + (w & 3); qpos = base + 4 * r32; kb0 = base - 256; }
    else { const int base = P0 + 32 * w; qpos = base + r32; kb0 = base - 64; }
}
template <int DIL> DI int a_kbase(int w, int kb0, int i) { if (DIL == 16) return (w + 8 * (i >> 2)) + 512 * (i & 3); else return kb0 + DIL * 32 * i; }
DI int a_clamp(int p) { return p < 0 ? 0 : (p > SEQ - 1 ? SEQ - 1 : p); }
template <int DIL> DI void a_issue_kv(APf& pf, const AHead& hp, int kb, int lane) {
    const int kbs = __builtin_amdgcn_readfirstlane(((unsigned)kb < (unsigned)SEQ) ? kb : 0);
    const char* sbk = (const char*)(hp.k + (size_t)kbs * 64); const char* sbv = (const char*)(hp.v + (size_t)kbs * 64);
#pragma unroll
    for (int j = 0; j < 4; ++j) { const int c = lane + 64 * j, r = c >> 3, ch = c & 7; const unsigned vo = (unsigned)(DIL * r * 64 + 8 * ch) * 2u;
        pf.kc[j] = *(const u32x4*)(sbk + vo); pf.vc[j] = *(const u32x4*)(sbv + vo); }
}
template <int DIL> DI void a_first_issue(APf& pf, const AHead& hp, int P0, int w, int lane) {
    const int r32 = lane & 31, h = lane >> 5; int qpos, kb0; a_geom<DIL>(P0, w, r32, qpos, kb0);
    const bf16_t* qr = hp.q + (size_t)qpos * 64 + 8 * h;
#pragma unroll
    for (int s = 0; s < 4; ++s) pf.qf[s] = *(const bf16x8*)(qr + 16 * s);
    a_issue_kv<DIL>(pf, hp, a_kbase<DIL>(w, kb0, 0), lane);
}
template <int DIL, int PASS, class NextFn>
DI void attnA_pass(LAS char* lds, const AHead& hp, float* ssq  , int P0, int w, int lane_, APf& pf, NextFn next_issue) {
    int lane = lane_; asm volatile("" : "+v"(lane));
    const int r32 = lane & 31, h = lane >> 5;
    int qpos, kb0; constexpr int NSUB = (DIL == 16) ? 8 : 5;
    a_geom<DIL>(P0, w, r32, qpos, kb0);
    const int qloc = qpos - P0;
    LAS float* ost = (LAS float*)lds; LAS float* ml = (LAS float*)(lds + A_ML_OFF); LAS char* vw = lds + A_VW_OFF + w * A_VWB;
    f32x16 o[2]; float mrun, lrun;
    if (PASS == 0) {
#pragma unroll
        for (int d = 0; d < 2; ++d)
#pragma unroll
            for (int i = 0; i < 16; ++i) o[d][i] = 0.f;
        mrun = NEGBIG; lrun = 0.f;
    } else {
#pragma unroll
        for (int d = 0; d < 2; ++d)
#pragma unroll
            for (int g = 0; g < 4; ++g) { const f32x4 t4 = *(const LAS f32x4*)(ost + qloc * A_OSTP + a_swz(qloc, 8 * d + 2 * g + h)); o[d][4 * g] = t4[0]; o[d][4 * g + 1] = t4[1]; o[d][4 * g + 2] = t4[2]; o[d][4 * g + 3] = t4[3]; }
        const f32x2 mlv = *(const LAS f32x2*)(ml + qloc * 2); mrun = mlv[0]; lrun = (h == 0) ? mlv[1] : 0.f;
    }
    auto kbase_of = [&](int i) -> int { return a_kbase<DIL>(w, kb0, i); };
    LAS char* kw = vw; LAS char* vw2 = vw + 32 * A_VP;
    auto issue = [&](int i) { a_issue_kv<DIL>(pf, hp, kbase_of(i), lane); };
    auto vstore = [&]() {
#pragma unroll
        for (int j = 0; j < 4; ++j) { const int c = lane + 64 * j, r = c >> 3, ch = c & 7; *(LAS u32x4*)(kw + r * A_VP + ch * 16) = pf.kc[j]; *(LAS u32x4*)(vw2 + r * A_VP + ch * 16) = pf.vc[j]; }
        asm volatile("" ::: "memory");
    };
    const int i16 = lane & 15, tq = i16 >> 2, tp = i16 & 3, blk = (lane >> 4) & 1;
    const int voff = (4 * h + tq) * A_VP + (16 * blk + 4 * tp) * 2;
    const int koff = r32 * A_VP + 16 * h;
    APf pb2;
    a_issue_kv<DIL>(pb2, hp, kbase_of(1), lane);
    auto vstoreB = [&]() {
#pragma unroll
        for (int j = 0; j < 4; ++j) { const int c = lane + 64 * j, r = c >> 3, ch = c & 7; *(LAS u32x4*)(kw + r * A_VP + ch * 16) = pb2.kc[j]; *(LAS u32x4*)(vw2 + r * A_VP + ch * 16) = pb2.vc[j]; }
        asm volatile("" ::: "memory");
    };
    bf16x8 qf[4];
#pragma unroll
    for (int s = 0; s < 4; ++s) qf[s] = pf.qf[s];
    auto compute = [&](int i) {
        const int kb = kbase_of(i);
        bool live;
        if (DIL == 16) { const int t0 = 32 * (i & 3), b16 = P0 >> 4; live = (t0 + 31 >= b16 - 64) && (t0 <= b16 + 79); }
        else live = (unsigned)kb < (unsigned)SEQ;
        if (live) {
        f32x16 st;
#pragma unroll
        for (int j = 0; j < 16; ++j) st[j] = 0.f;
#pragma unroll
        for (int s = 0; s < 4; ++s) { const bf16x8 ka = *(const LAS bf16x8*)(kw + koff + 32 * s); st = MFMA32(ka, qf[s], st); }
        if (DIL == 16) {
            const bool cm = ((i >> 2) == (r32 >> 4));
            const int jq = (P0 >> 4) + (r32 & 15);
            const int tt = cm ? (32 * (i & 3) + 4 * h - jq + 64) : 0x40000000;
#pragma unroll
            for (int j = 0; j < 16; ++j) st[j] = ((unsigned)(tt + ((j & 3) + 8 * (j >> 2))) <= 128u) ? st[j] : NEGBIG;
        } else if (i == 0) {
#pragma unroll
            for (int j = 0; j < 16; ++j) st[j] = (crow(j, h) >= r32) ? st[j] : NEGBIG;
        } else if (i == 4) {
#pragma unroll
            for (int j = 0; j < 16; ++j) st[j] = (crow(j, h) <= r32) ? st[j] : NEGBIG;
        }
        float mx = max16(st); mx = xhalf_max(mx);
        const float mnew = fmaxf(mrun, mx);
        if (__builtin_amdgcn_ballot_w64(mnew > mrun) != 0ull) { const float alpha = fast_exp2(mrun - mnew); lrun = lrun * alpha; o[0] = o[0] * alpha; o[1] = o[1] * alpha; }
        mrun = mnew;
        float rs = 0.f;
#pragma unroll
        for (int j = 0; j < 16; ++j) { st[j] = fast_exp2(st[j] - mnew); rs += st[j]; }
        lrun = lrun + rs;
#pragma unroll
        for (int ks = 0; ks < 2; ++ks) {
            const bf16x8 pb = pack8(st, ks);
            const LAS char* vr = vw2 + voff + (16 * ks) * A_VP;
#pragma unroll
            for (int d = 0; d < 2; ++d) {
                const s16x4 lo = vtr(vr + d * 64), hi = vtr(vr + 8 * A_VP + d * 64);
                const bf16x8 va = __builtin_shufflevector(lo, hi, 0, 1, 2, 3, 4, 5, 6, 7);
                o[d] = MFMA32(va, pb, o[d]);
            }
        }
        }
        asm volatile("" ::: "memory");
    };
    vstore();
#pragma unroll
    for (int s = 0; s < 4; ++s) asm volatile("" : "+v"(qf[s]));
    if (2 < NSUB) issue(2);
    compute(0);
#pragma unroll 1
    for (int i = 1; i < NSUB; i += 2) {
        vstoreB(); if (i + 2 < NSUB) a_issue_kv<DIL>(pb2, hp, kbase_of(i + 2), lane); compute(i);
        if (i + 1 < NSUB) { vstore(); if (i + 3 < NSUB) issue(i + 3); compute(i + 1); }
    }
    next_issue();
    if (PASS < 2) {
#pragma unroll
        for (int d = 0; d < 2; ++d)
#pragma unroll
            for (int g = 0; g < 4; ++g) *(LAS f32x4*)(ost + qloc * A_OSTP + a_swz(qloc, 8 * d + 2 * g + h)) = (f32x4){o[d][4 * g], o[d][4 * g + 1], o[d][4 * g + 2], o[d][4 * g + 3]};
        const float ltot = lrun + __shfl_xor(lrun, 32);
        if (h == 0) *(LAS f32x2*)(ml + qloc * 2) = (f32x2){mrun, ltot};
    } else {
        const float ltot = lrun + __shfl_xor(lrun, 32), inv = 1.0f / ltot;
        const int q0pos = qpos - r32;
        epi_rows<64>((LAS float*)vw, o, inv, hp.gate + (size_t)q0pos * NP, NP, ssq + (size_t)q0pos * 32, lane);
    }
}

DI int win_dst(int n, float& scale) {
    scale = 1.0f;
    if (n < 2048) { const int d = n & 63, base = n - d; if (n < 1024) scale = 0.125f * LOG2E; return base + (d < 16 ? ((d & 7) * 2 + (d >> 3)) : d); }
    if (n < 4096) return n;
    if (n < 4352) return WOFF + C_CQ + (n - 4096);
    if (n < 4480) return WOFF + C_CKV + (n - 4352);
    if (n < 4512) { const int d = n - 4480; return WOFF + C_KR + ((d & 15) * 2 + (d >> 4)); }
    if (n < 5024) return WOFF + C_BG + (n - 4512);
    if (n < 5536) { scale = 0.08838834764831845f * LOG2E; return WOFF + C_MQ + (n - 5024); }
    return WOFF + C_MG + (n - 5536);
}
template <int MODE>
DI void tr_item(const float* W, int K, int N, bf16_t* WT, const float* g0, const float* g1, const float* g2, LAS float* scr, int item, int lane) {
    const int nblk = N / 32, kb = item / nblk, nb = item % nblk, k0 = 64 * kb, n0 = 32 * nb;
    float wv[32];
#pragma unroll
    for (int i = 0; i < 32; ++i) { const int kk = 2 * i + (lane >> 5); wv[i] = W[(size_t)(k0 + kk) * N + n0 + (lane & 31)]; }
#pragma unroll
    for (int i = 0; i < 32; ++i) { const int kk = 2 * i + (lane >> 5); scr[kk * 33 + (lane & 31)] = wv[i]; }
    asm volatile("s_waitcnt lgkmcnt(0)" ::: "memory");
    const int c = lane & 7;
    float gk[8];
#pragma unroll
    for (int e = 0; e < 8; ++e) { const int k = k0 + 8 * c + e;
        if (MODE == 1 || MODE == 2) gk[e] = g0[k];
        else if (MODE == 4) gk[e] = (k < 1024) ? g0[k] : (k < 1536 ? g1[k - 1024] : g2[k - 1536]);
        else gk[e] = 1.0f; }
#pragma unroll
    for (int j = 0; j < 4; ++j) {
        const int nl = (lane >> 3) + 8 * j, n = n0 + nl; float sc = 1.0f; int dst = n;
        if (MODE == 0) dst = win_dst(n, sc);
        if (MODE == 1) { const int hd = n / 96, d = n % 96; sc = 0.10206207261596575f * LOG2E; if (d >= 64) { const int r = d - 64; dst = hd * 96 + 64 + ((r & 15) * 2 + (r >> 4)); } }
        const LAS float* s = scr + (8 * c) * 33 + nl;
        u32x4 o4; o4.x = cvtpk(s[0 * 33] * gk[0] * sc, s[1 * 33] * gk[1] * sc); o4.y = cvtpk(s[2 * 33] * gk[2] * sc, s[3 * 33] * gk[3] * sc);
        o4.z = cvtpk(s[4 * 33] * gk[4] * sc, s[5 * 33] * gk[5] * sc); o4.w = cvtpk(s[6 * 33] * gk[6] * sc, s[7 * 33] * gk[7] * sc);
        *(u32x4*)(WT + (size_t)dst * K + k0 + 8 * c) = o4;
    }
    asm volatile("s_waitcnt lgkmcnt(0)" ::: "memory");
}

__constant__ double INVF_A[8] = {1.0, 0.19390103887252767, 0.037597612875247145, 0.007290216193692821, 0.0014135804504232794, 0.00027409471785274054, 5.3147250536566735e-05, 1.0305307092165658e-05};
__constant__ double INVF_B[16] = {1.0, 0.44034195675670255, 0.19390103887252767, 0.08538276288621138, 0.037597612875247145, 0.016555806424970463, 0.007290216193692821, 0.0032101880639213203,
                                  0.0014135804504232794, 0.0006224587813827168, 0.00027409471785274054, 0.00012069540440475095, 5.3147250536566735e-05, 2.3402964294289857e-05, 1.0305307092165658e-05, 4.537859090181327e-06};


#define XB_TMO      128
#define XB_XCNT(j)  (256  + 64 * (j))
#define XB_XSUB(j)  (1280 + 64 * (j))
#define XB_XGEN(j)  (2304 + 64 * (j))
#define XB_TOP      3328
#define XB_TOPGEN   3392
#define XCD_BAR_WORDS 3456
#define XB_SPIN_CAP (1u << 18)
DI unsigned xb_ld(unsigned* p)              { return __hip_atomic_load(p, __ATOMIC_RELAXED, __HIP_MEMORY_SCOPE_AGENT); }
DI unsigned xb_add(unsigned* p, unsigned v) { return __hip_atomic_fetch_add(p, v, __ATOMIC_RELAXED, __HIP_MEMORY_SCOPE_AGENT); }
DI unsigned xb_xcc_id() { return (unsigned)__builtin_amdgcn_s_getreg((3 << 11) | 20) & 0xFu; }
#define XB_SPIN(cond, bar) do { unsigned _sp = 0; while (cond) { __builtin_amdgcn_s_sleep(1); \
    if ((++_sp & 255u) == 0u) { if (xb_ld(&(bar)[XB_TMO])) break; if (_sp > XB_SPIN_CAP) { atomicAdd(&(bar)[XB_TMO], 1u); break; } } } } while (0)
struct XcdBarrier { unsigned* bar; unsigned x; volatile LAS unsigned* st; };
DI XcdBarrier xcd_barrier_post(unsigned* bar, volatile LAS unsigned* st) {
    XcdBarrier b; b.bar = bar; b.x = xb_xcc_id(); b.st = st;
    if (threadIdx.x == 0) (void)xb_add(&bar[XB_XCNT(b.x)], 1u);
    return b;
}
DI void xcd_barrier_complete(unsigned* bar, unsigned x, unsigned& nloc, unsigned& nx) {
    const unsigned G = gridDim.x * gridDim.y * gridDim.z;
    unsigned sum, cnt, mine, sp = 0u;
    for (;;) {
        sum = 0u; cnt = 0u; mine = 0u;
#pragma unroll
        for (unsigned j = 0; j < 16; ++j) { const unsigned c = xb_ld(&bar[XB_XCNT(j)]); sum += c; cnt += (c > 0u) ? 1u : 0u; mine = (j == x) ? c : mine; }
        if (sum == G) break;
        __builtin_amdgcn_s_sleep(1);
        if ((++sp & 255u) == 0u) { if (xb_ld(&bar[XB_TMO])) break; if (sp > XB_SPIN_CAP) { atomicAdd(&bar[XB_TMO], 1u); break; } }
    }
    nloc = mine > 0u ? mine : 1u; nx = cnt > 0u ? cnt : 1u;
}
DI void xcd_barrier(const XcdBarrier& b) {
    asm volatile("s_waitcnt vmcnt(0)" ::: "memory");
    __syncthreads();
    if (threadIdx.x == 0) {
        unsigned* bar = b.bar;
        __builtin_amdgcn_s_waitcnt(0);
        unsigned nloc = b.st[0], nx = b.st[1];
        if (nloc == 0u) { xcd_barrier_complete(bar, b.x, nloc, nx); b.st[0] = nloc; b.st[1] = nx; }
        const unsigned old = xb_add(&bar[XB_XSUB(b.x)], 1u);
        const unsigned gen = old / nloc;
        if (old + 1u == (gen + 1u) * nloc) {
            __builtin_amdgcn_fence(__ATOMIC_RELEASE, "agent");
            asm volatile("s_waitcnt vmcnt(0)" ::: "memory");
            const unsigned og = xb_add(&bar[XB_TOP], 1u);
            const unsigned tg = og / nx;
            if (og + 1u == (tg + 1u) * nx) xb_add(&bar[XB_TOPGEN], 1u);
            else XB_SPIN(xb_ld(&bar[XB_TOPGEN]) == tg, bar);
            __builtin_amdgcn_fence(__ATOMIC_ACQUIRE, "agent");
            xb_add(&bar[XB_XGEN(b.x)], 1u);
            asm volatile("s_waitcnt vmcnt(0)" ::: "memory");
        } else {
            XB_SPIN(xb_ld(&bar[XB_XGEN(b.x)]) == gen, bar);
            __builtin_amdgcn_fence(__ATOMIC_ACQUIRE, "agent");
            asm volatile("s_waitcnt vmcnt(0)" ::: "memory");
        }
    }
    __syncthreads();
}

struct Args {
    const float* x; const float* mem; const int* pos; const float* g_emb; const float* b_emb; const float* w_in; const float* g_cq; const float* g_ckv;
    const float* w_uq; const float* w_ukv; const float* w_mem_kv; const float* g_out_a; const float* g_out_b; const float* g_out_m; const float* w_out;
    const float* g_post; const float* b_post; float* out; unsigned char* ws; int ph_lo, ph_hi;
};

__global__ void __launch_bounds__(NTHREADS, 2) fwd_mega(Args a) {
    extern __shared__ __attribute__((aligned(16))) unsigned char lds_raw[];
    LAS unsigned char* lds = (LAS unsigned char*)lds_raw;
    cg::grid_group grid = cg::this_grid();
    const int tid = threadIdx.x, lane = tid & 63, wave = __builtin_amdgcn_readfirstlane(tid >> 6);
    const int G = gridDim.x, bx = blockIdx.x;
    const int gw = bx * 8 + wave, NGW = G * 8;
    unsigned char* ws = a.ws;
    bf16_t* PROJ = (bf16_t*)(ws + WS_PROJ); bf16_t* QHB = (bf16_t*)(ws + WS_QH); bf16_t* KRB = (bf16_t*)(ws + WS_KR); bf16_t* KVB = (bf16_t*)(ws + WS_KVB); bf16_t* WIN = (bf16_t*)(ws + WS_WIN); bf16_t* WOUT = (bf16_t*)(ws + WS_WOUT);
    bf16_t* WMEM = (bf16_t*)(ws + WS_WMEM); bf16_t* WUQ = (bf16_t*)(ws + WS_WUQ); bf16_t* WUKV = (bf16_t*)(ws + WS_WUKV); bf16_t* MEMB = (bf16_t*)(ws + WS_MEMB);
    bf16_t* MKV = (bf16_t*)(ws + WS_MKV); float* ROPEA = (float*)(ws + WS_ROPEA); float* ROPEB = (float*)(ws + WS_ROPEB); float* XSTAT = (float*)(ws + WS_XSTAT);
    float* SSQQ = (float*)(ws + WS_SSQQ); float* SSQKV = (float*)(ws + WS_SSQKV); float* SSQY = (float*)(ws + WS_SSQY); float* PSTAT = (float*)(ws + WS_PSTAT);
    bf16_t* H = (bf16_t*)((unsigned char*)a.out + OUT_H); bf16_t* QB = (bf16_t*)((unsigned char*)a.out + OUT_QB);
    const int lo = a.ph_lo, hi = a.ph_hi;
    volatile LAS unsigned* xst = (volatile LAS unsigned*)(lds + LDS_BYTES - 64);
    if (tid < 2) xst[tid] = 0u;
    __syncthreads();
    const XcdBarrier xbar = xcd_barrier_post((unsigned*)(ws + WS_BAR), xst);
#ifndef PH_MASK
#define PH_MASK 63
#endif
#define IN(k) (((PH_MASK >> (k)) & 1) && lo <= (k) && (k) < hi)
#define SEAM(k) do { if (IN(k) && IN((k) + 1)) { if (lo < 0) grid.sync(); else xcd_barrier(xbar); } } while (0)
#ifndef DUP_MASK
#define DUP_MASK 0
#endif
#define REPS(k) ((((DUP_MASK) >> (k)) & 1) + 1)

    if (IN(0)) for (int rep = 0; rep < REPS(0); ++rep) { if (rep) grid.sync();
        LAS float* scr = (LAS float*)(lds + wave * 16384);
        constexpr int I_IN = (1024 / 64) * (6048 / 32), I_UQ = (256 / 64) * (768 / 32), I_UKV = (128 / 64) * (1024 / 32), I_MEM = (1024 / 64) * (1024 / 32), I_OUT = (2048 / 64) * (1024 / 32);
        constexpr int NITEMS = I_IN + I_UQ + I_UKV + I_MEM + I_OUT;
        for (int it = gw; it < NITEMS; it += NGW) {
            int r = it;
            if (r < I_IN) { tr_item<0>(a.w_in, 1024, 6048, WIN, nullptr, nullptr, nullptr, scr, r, lane); continue; } r -= I_IN;
            if (r < I_UQ) { tr_item<1>(a.w_uq, 256, 768, WUQ, a.g_cq, nullptr, nullptr, scr, r, lane); continue; } r -= I_UQ;
            if (r < I_UKV) { tr_item<2>(a.w_ukv, 128, 1024, WUKV, a.g_ckv, nullptr, nullptr, scr, r, lane); continue; } r -= I_UKV;
            if (r < I_MEM) { tr_item<3>(a.w_mem_kv, 1024, 1024, WMEM, nullptr, nullptr, nullptr, scr, r, lane); continue; } r -= I_MEM;
            tr_item<4>(a.w_out, 2048, 1024, WOUT, a.g_out_a, a.g_out_b, a.g_out_m, scr, r, lane);
        }
        for (int i = bx * NTHREADS + tid; i < 96 * 1024 / 8; i += G * NTHREADS) *(u32x4*)(WIN + (size_t)6048 * 1024 + (size_t)i * 8) = (u32x4){0u, 0u, 0u, 0u};
        {
            f32x4 gg[4], bb[4];
#pragma unroll
            for (int j = 0; j < 4; ++j) { gg[j] = *((const f32x4*)a.g_emb + lane + 64 * j); bb[j] = *((const f32x4*)a.b_emb + lane + 64 * j); }
            f32x4 nx[4];
            if (gw < T) {
#pragma unroll
                for (int j = 0; j < 4; ++j) nx[j] = *((const f32x4*)(a.x + (size_t)gw * DM) + lane + 64 * j);
            }
            for (int m = gw; m < T; m += NGW) {
                f32x4 v[4]; float s = 0.f;
#pragma unroll
                for (int j = 0; j < 4; ++j) { v[j] = nx[j]; s += (v[j][0] + v[j][1]) + (v[j][2] + v[j][3]); }
                if (m + NGW < T) {
#pragma unroll
                    for (int j = 0; j < 4; ++j) nx[j] = *((const f32x4*)(a.x + (size_t)(m + NGW) * DM) + lane + 64 * j);
                }
                const float mean = wave_sum(s) * (1.f / DM); float s2 = 0.f;
#pragma unroll
                for (int j = 0; j < 4; ++j) { v[j] = v[j] - mean; s2 += (v[j][0] * v[j][0] + v[j][1] * v[j][1]) + (v[j][2] * v[j][2] + v[j][3] * v[j][3]); }
                const float rstd = 1.0f / sqrtf(wave_sum(s2) * (1.f / DM) + EPS);
                if (lane == 0) *(f32x2*)(XSTAT + (size_t)m * 2) = (f32x2){mean, rstd};
#pragma unroll
                for (int j = 0; j < 4; ++j) {
                    const f32x4 y = v[j] * rstd * gg[j] + bb[j];
                    u32x2 o2; o2.x = cvtpk(y[0], y[1]); o2.y = cvtpk(y[2], y[3]);
                    *((u32x2*)(H + (size_t)m * DM) + lane + 64 * j) = o2;
                }
            }
        }
        for (int m = gw; m < BATCH * NMEM; m += NGW) {
#pragma unroll
            for (int j = 0; j < 4; ++j) { const f32x4 y = *((const f32x4*)(a.mem + (size_t)m * DM) + lane + 64 * j); u32x2 o2; o2.x = cvtpk(y[0], y[1]); o2.y = cvtpk(y[2], y[3]); *((u32x2*)(MEMB + (size_t)m * DM) + lane + 64 * j) = o2; }
        }
        for (int i = bx * NTHREADS + tid; i < T * 24; i += G * NTHREADS) {
            const int t = i / 24, j = i % 24;
            const double p = (double)a.pos[t];
            const double ang = p * (j < 8 ? INVF_A[j] : INVF_B[j - 8]);
            double rev = ang * 0.15915494309189535; rev = rev - floor(rev);
            const float fr = (float)rev;
            const float cs = __builtin_amdgcn_cosf(fr), sn = __builtin_amdgcn_sinf(fr);
            float* d = (j < 8) ? (ROPEA + (size_t)t * 16 + 2 * j) : (ROPEB + (size_t)t * 32 + 2 * (j - 8));
            *(f32x2*)d = (f32x2){cs, sn};
        }
    }
    SEAM(0);
#ifdef EXTRA_SYNC
    for (int e = 0; e < EXTRA_SYNC; ++e) grid.sync();
#endif

    if (IN(1)) for (int rep = 0; rep < REPS(1); ++rep) { if (rep) grid.sync();
        pg8::Gemm g{H, WIN, DM, DM, DM}; pg8::StaticOrder S; S.init(T, N1, G, bx);
        EpiProj E{PROJ, QHB, KRB, ROPEA, ROPEB, SSQQ, SSQKV};
        pg8::gemm_phase<EpiProj, false>(lds, g, S, E);
    }
    SEAM(1);

    if (IN(2)) for (int rep = 0; rep < REPS(2); ++rep) { if (rep) grid.sync();
#ifndef P2_MASK
#define P2_MASK 7
#endif
        const int G3 = (G * 3) / 4, Gm = G - G3; const bool tail = (bx >= G3);
        if (P2_MASK & 1) { pg8::Gemm g{PROJ + C_CQ, WUQ, NP, 256, 256}; pg8::StaticOrder S; S.init(T, 768, G3, tail ? -1 : bx); EpiQ E{QB, ROPEB, SSQQ}; pg8::gemm_phase<EpiQ, false>(lds, g, S, E); }
        if (P2_MASK & 2) { pg8::Gemm g{PROJ + C_CKV, WUKV, NP, 128, 128}; pg8::StaticOrder S; S.init(T, 1024, tail ? Gm : G3, tail ? bx - G3 : bx);
            const int nkv = (T / 256) * 4; if (tail) S.window(nkv - Gm, nkv); else S.window(0, nkv - Gm);
            EpiKV E{KVB, SSQKV}; pg8::gemm_phase<EpiKV, false>(lds, g, S, E); }
        if (P2_MASK & 4) { pg8::Gemm g{MEMB, WMEM, DM, DM, DM}; pg8::StaticOrder S; S.init(BATCH * NMEM, 1024, Gm, tail ? bx - G3 : -1); EpiPlain E{MKV, 1024}; pg8::gemm_phase<EpiPlain, false>(lds, g, S, E); }
    }
    SEAM(2);

    if (IN(3)) {
        constexpr int U_B = BATCH * 8 * 4, U_A = BATCH * 16 * 8, U_M = BATCH * 4 * 8;
        const bool xcdmap = (G % 8 == 0);
        auto unit_of = [&](int it_) -> int {
            if (xcdmap) { const int L = it_ * (G >> 3) + (bx >> 3), g = (L >> 3) * 8 + (bx & 7); return (g >= (U_B + U_A + U_M) / 8) ? -1 : g * 8 + (L & 7); }
            const int u_ = bx + it_ * G; return (u_ >= U_B + U_A + U_M) ? -1 : u_;
        };
        for (int it = 0;; ++it) {
            const int u = unit_of(it); if (u < 0) break;
#ifndef ATT_MASK
#define ATT_MASK 7
#endif
            if (u < U_B) { if (ATT_MASK & 1) {
                const int b = u / 32, hd = (u >> 2) & 7, qb = u & 3; const size_t r0 = (size_t)b * SEQ, rq = r0 + qb * 512;
                const size_t hb = ((size_t)(b * 8 + hd) * SEQ) * 128;
                attn_dense_unit<96, 64, 64, 2>((LAS char*)lds, QB + rq * 768 + hd * 96, 768, KVB + hb, 128, KRB + r0 * 32, 32,
                                            KVB + hb + 64, 128, SEQ, PROJ + rq * NP + C_BG + hd * 64, NP, SSQY + rq * 32 + 16 + hd);
            } } else if (u < U_B + U_A) { if (ATT_MASK & 2) {
                APf pf;
                auto mk_head = [&](int v_) -> AHead { const int b_ = v_ / 128, hd_ = (v_ >> 3) & 15; const size_t hb = ((size_t)(b_ * 16 + hd_) * SEQ) * 64, tq = (size_t)T * 1024;
                    return AHead{QHB + hb, QHB + tq + hb, QHB + 2 * tq + hb, PROJ + (size_t)b_ * SEQ * NP + C_AG + hd_ * 64}; };
                { const int v = u - U_B; const AHead h0 = mk_head(v); a_first_issue<16>(pf, h0, (v & 7) * 256, wave, lane); }
                for (;;) {
                    const int ucur = unit_of(it);
                    const int v = ucur - U_B, b = v / 128, hd = (v >> 3) & 15, blk = v & 7; const int P0 = blk * 256;
                    const AHead hp = mk_head(v);
                    float* ssqa = SSQY + (size_t)b * SEQ * 32 + hd;
                    attnA_pass<16, 0>((LAS char*)lds, hp, ssqa, P0, wave, lane, pf, [&]() { a_first_issue<4>(pf, hp, P0, wave, lane); }); __syncthreads();
                    attnA_pass<4, 1>((LAS char*)lds, hp, ssqa, P0, wave, lane, pf, [&]() { a_first_issue<1>(pf, hp, P0, wave, lane); }); __syncthreads();
                    const int u2 = unit_of(it + 1); const bool nextA = (u2 >= U_B && u2 < U_B + U_A);
                    const int v2 = nextA ? u2 - U_B : v; const AHead hp2 = mk_head(v2); const int P02 = (v2 & 7) * 256;
                    attnA_pass<1, 2>((LAS char*)lds, hp, ssqa, P0, wave, lane, pf, [&]() { if (nextA) a_first_issue<16>(pf, hp2, P02, wave, lane); });
                    __syncthreads();
                    if (!nextA) break;
                    ++it;
                }
            } } else { if (ATT_MASK & 4) {
                const int v = u - U_B - U_A, b = v / 32, hd = (v >> 3) & 3, qb = v & 7; const size_t rq = (size_t)b * SEQ + qb * 256, rm = (size_t)b * NMEM;
                attn_dense_unit<128, 128, 128, 1>((LAS char*)lds, PROJ + rq * NP + C_MQ + hd * 128, NP, MKV + rm * 1024 + hd * 128, 1024, MKV, 1024,
                                               MKV + rm * 1024 + 512 + hd * 128, 1024, NMEM, PROJ + rq * NP + C_MG + hd * 128, NP, SSQY + rq * 32 + 24 + hd);
            } }
        }
    }
    SEAM(3);

    if (IN(4)) for (int rep = 0; rep < REPS(4); ++rep) { if (rep) grid.sync();
        pg8::Gemm g{PROJ + C_AG, WOUT, NP, 2048, 2048}; pg8::StaticOrder S; S.init(T, DM, G, bx);
        LAS f32x4* rtab = (LAS f32x4*)(lds + pg8::STAGE_BYTES);
        for (int i = 0; i < 2; ++i) { Unit u;
            if (S.next(i, u) && tid < 256) {
                const float* sp = SSQY + ((size_t)u.pm * 256 + tid) * 32;
                float sa = 0.f, sb = 0.f, sm = 0.f;
#pragma unroll
                for (int j = 0; j < 4; ++j) { const f32x4 t4 = *(const f32x4*)(sp + 4 * j); sa += (t4[0] + t4[1]) + (t4[2] + t4[3]); }
#pragma unroll
                for (int j = 4; j < 6; ++j) { const f32x4 t4 = *(const f32x4*)(sp + 4 * j); sb += (t4[0] + t4[1]) + (t4[2] + t4[3]); }
                { const f32x4 t4 = *(const f32x4*)(sp + 24); sm = (t4[0] + t4[1]) + (t4[2] + t4[3]); }
                const float ra = __builtin_amdgcn_rsqf(sa * (1.0f / 1024.0f) + EPS), rb = __builtin_amdgcn_rsqf(sb * (1.0f / 512.0f) + EPS), rm = __builtin_amdgcn_rsqf(sm * (1.0f / 512.0f) + EPS);
                rtab[i * 256 + tid] = (f32x4){ra / rb, rb / rm, rm, 0.f};
            } }
        __syncthreads();
        EpiOut E{QHB, H, PSTAT, rtab};
        pg8::gemm_phase<EpiOut, true>(lds, g, S, E);
    }
    SEAM(4);

    if (IN(5)) {
        f32x4 gg[4], bb[4];
#pragma unroll
        for (int j = 0; j < 4; ++j) { gg[j] = *((const f32x4*)a.g_post + lane + 64 * j); bb[j] = *((const f32x4*)a.b_post + lane + 64 * j); }
        u32x2 npk[4]; f32x2 np = {0.f, 0.f};
        if (gw < T) {
            if (lane < 16) np = *(const f32x2*)(PSTAT + ((size_t)gw * 16 + lane) * 2);
#pragma unroll
            for (int j = 0; j < 4; ++j) npk[j] = *((const u32x2*)(QHB + (size_t)gw * DM) + lane + 64 * j);
        }
        for (int m = gw; m < T; m += NGW) {
            float s = np[0], q = np[1];
            u32x2 pk[4];
#pragma unroll
            for (int j = 0; j < 4; ++j) pk[j] = npk[j];
            if (m + NGW < T) {
                np = (f32x2){0.f, 0.f};
                if (lane < 16) np = *(const f32x2*)(PSTAT + ((size_t)(m + NGW) * 16 + lane) * 2);
#pragma unroll
                for (int j = 0; j < 4; ++j) npk[j] = *((const u32x2*)(QHB + (size_t)(m + NGW) * DM) + lane + 64 * j);
            }
            s = wave_sum(s); q = wave_sum(q);
            const float mean = s * (1.f / DM), var = fmaxf(q * (1.f / DM) - mean * mean, 0.f), rstd = 1.0f / sqrtf(var + EPS);
            f32x4* orow = (f32x4*)(a.out + (size_t)m * DM) + lane;
#pragma unroll
            for (int j = 0; j < 4; ++j) {
                const f32x4 v = {__builtin_bit_cast(float, pk[j].x << 16), __builtin_bit_cast(float, pk[j].x & 0xffff0000u), __builtin_bit_cast(float, pk[j].y << 16), __builtin_bit_cast(float, pk[j].y & 0xffff0000u)};
                orow[64 * j] = (v - mean) * rstd * gg[j] + bb[j];
            }
        }
    }
#undef IN
#undef SEAM
}

extern "C" void kernel_launch(void* const* d_in, const int* in_sizes, int n_in, void* d_out, int out_size, void* d_ws, size_t ws_size, hipStream_t stream) {
    static int grid_blocks = 0;
    if (grid_blocks == 0) {
        int dev = 0, cus = 0, per_cu = 0;
        hipGetDevice(&dev);
        hipDeviceGetAttribute(&cus, hipDeviceAttributeMultiprocessorCount, dev);
        hipFuncSetAttribute((const void*)fwd_mega, hipFuncAttributeMaxDynamicSharedMemorySize, LDS_BYTES);
        hipOccupancyMaxActiveBlocksPerMultiprocessor(&per_cu, (const void*)fwd_mega, NTHREADS, LDS_BYTES);
        if (per_cu < 1) { fprintf(stderr, "kernel_launch: occupancy query reports %d blocks/CU\n", per_cu); per_cu = 1; }
        if (per_cu > 1) per_cu = 1;
        grid_blocks = cus * per_cu;
        if (ws_size < WS_END) { fprintf(stderr, "kernel_launch: workspace too small (%zu < %zu)\n", ws_size, (size_t)WS_END); }
    }
    (void)hipMemsetAsync((unsigned char*)d_ws + WS_BAR, 0, XCD_BAR_WORDS * 4, stream);
    Args a{};
    a.x = (const float*)d_in[0]; a.mem = (const float*)d_in[1]; a.pos = (const int*)d_in[2]; a.g_emb = (const float*)d_in[3]; a.b_emb = (const float*)d_in[4];
    a.w_in = (const float*)d_in[5]; a.g_cq = (const float*)d_in[6]; a.g_ckv = (const float*)d_in[7]; a.w_uq = (const float*)d_in[8]; a.w_ukv = (const float*)d_in[9];
    a.w_mem_kv = (const float*)d_in[10]; a.g_out_a = (const float*)d_in[11]; a.g_out_b = (const float*)d_in[12]; a.g_out_m = (const float*)d_in[13]; a.w_out = (const float*)d_in[14];
    a.g_post = (const float*)d_in[15]; a.b_post = (const float*)d_in[16]; a.out = (float*)d_out; a.ws = (unsigned char*)d_ws; a.ph_lo = 0; a.ph_hi = 6;
    void* args[] = {&a};
    hipError_t e = hipLaunchCooperativeKernel((const void*)fwd_mega, dim3(grid_blocks), dim3(NTHREADS), args, LDS_BYTES, stream);
    if (e != hipSuccess) fprintf(stderr, "cooperative launch failed: %s (grid %d)\n", hipGetErrorString(e), grid_blocks);
}
```

```cpp
#include <hip/hip_runtime.h>
#include <hip/hip_cooperative_groups.h>
#include <cstdio>
#include <cstdint>
namespace cg = cooperative_groups;

#define LAS __attribute__((address_space(3)))
#define DI __device__ __forceinline__
typedef unsigned short bf16_t;
typedef short bf16x8 __attribute__((ext_vector_type(8)));
typedef short s16x4 __attribute__((ext_vector_type(4)));
typedef float f32x4 __attribute__((ext_vector_type(4)));
typedef float f32x2 __attribute__((ext_vector_type(2)));
typedef float f32x16 __attribute__((ext_vector_type(16)));
typedef unsigned u32x4 __attribute__((ext_vector_type(4)));
typedef unsigned u32x2 __attribute__((ext_vector_type(2)));
typedef __bf16 bf16x2_t __attribute__((ext_vector_type(2)));

constexpr int BATCH = 16, SEQ = 2048, DM = 1024, T = BATCH * SEQ, NMEM = 256;
constexpr int N1 = 6144;
constexpr int NP = 3072, WOFF = 3072;
constexpr int C_AG = 0, C_BG = 1024, C_MG = 1536, C_MQ = 2048, C_CQ = 2560, C_CKV = 2816, C_KR = 2944;
constexpr float EPS = 1e-5f;
constexpr float LOG2E = 1.4426950408889634f;
constexpr float ALPHA = 1.189207115002721f;
constexpr float NEGBIG = -1e30f;

constexpr size_t MiB = 1u << 20;
constexpr size_t WS_PROJ = 0, WS_QH = 192 * MiB  , WS_KVB = 384 * MiB, WS_WIN = 448 * MiB, WS_WOUT = 460 * MiB, WS_WMEM = 464 * MiB, WS_WUQ = 466 * MiB, WS_WUKV = 467 * MiB,
                 WS_MEMB = 468 * MiB, WS_MKV = 476 * MiB, WS_ROPEA = 484 * MiB, WS_ROPEB = 486 * MiB, WS_XSTAT = 490 * MiB, WS_SSQQ = 491 * MiB, WS_SSQKV = 492 * MiB,
                 WS_SSQY = 493 * MiB, WS_PSTAT = 497 * MiB, WS_BAR = 501 * MiB, WS_KR = 502 * MiB  , WS_END = 504 * MiB;
constexpr size_t OUT_H = 0, OUT_QB = 64 * MiB;

constexpr int LDS_BYTES = 155648;
constexpr int NTHREADS = 512;

DI unsigned cvtpk(float lo, float hi) { f32x2 v = {lo, hi}; bf16x2_t b = __builtin_convertvector(v, bf16x2_t); return __builtin_bit_cast(unsigned, b); }
DI float bf2f(unsigned short u) { return __builtin_bit_cast(float, (unsigned)u << 16); }
DI float wave_sum(float v) {
#pragma unroll
    for (int o = 1; o < 64; o <<= 1) v += __shfl_xor(v, o);
    return v;
}
DI float fast_exp2(float x) { return __builtin_amdgcn_exp2f(x); }
DI float silu(float g) { return g * __builtin_amdgcn_rcpf(1.0f + fast_exp2(-g * LOG2E)); }

namespace pg8 {
constexpr int BM = 256, BK = 64, HALF = 128, HTB = HALF * BK * 2, STAGE_BYTES = 8 * HTB, NXCD = 8, WGM = 8;
__host__ __device__ __forceinline__ int lds_byte(int r, int c) { const int st = (r >> 4) * 2 + (c >> 5), rr = r & 15, cc = c & 31, ob = rr * 64 + cc * 2; return st * 1024 + (ob ^ (((ob >> 9) & 1) << 5)); }
__host__ __device__ __forceinline__ void stage_rc(int b, int& R, int& C) { const int st = b / 1024, sb = b % 1024, swz = sb ^ (((sb >> 9) & 1) << 5); R = (st >> 1) * 16 + swz / 64; C = (st & 1) * 32 + (swz % 64) / 2; }
__host__ __device__ __forceinline__ int perm32(int rho) { const int n = rho >> 4, i = rho & 15; return 8 * (i >> 2) + 4 * n + (i & 3); }

struct Unit { int pm, pn; };
struct Gemm { const bf16_t* A; const bf16_t* Bt; int lda, ldb, K; };

struct StaticOrder {
    int nM, nN, nwg, G, c, base, limit;
    __device__ void init(int M, int N, int G_, int c_) { nM = M / BM; nN = N / BM; nwg = nM * nN; G = G_; c = c_; base = 0; limit = nwg; }
    __device__ void window(int base_, int limit_) { base = base_; limit = limit_; }
    __device__ bool next(int i, Unit& u) const {
        const long L = (long)base + (long)i * G + c; if (c < 0 || L >= limit) return false;
        int wgid = (int)L; { const int q = nwg / NXCD, r = nwg % NXCD, xcd = wgid % NXCD, off = wgid / NXCD; wgid = (xcd < r ? xcd * (q + 1) : r * (q + 1) + (xcd - r) * q) + off; }
        const int nig = WGM * nN, gid = wgid / nig, fm = gid * WGM, gsz = (nM - fm) < WGM ? (nM - fm) : WGM;
        u.pm = fm + ((wgid % nig) % gsz); u.pn = (wgid % nig) / gsz; return true;
    }
};

template <class Epi, bool HOOK>
DI void gemm_phase(LAS unsigned char* lds, const Gemm g, const StaticOrder& S, const Epi& E) {
    int tid_ = threadIdx.x; asm volatile("" : "+v"(tid_));
    const int tid = tid_, wid = __builtin_amdgcn_readfirstlane(tid >> 6), lane = tid & 63, wr = wid >> 2, wc = wid & 3, fr = lane & 15, fq = lane >> 4;
    const int K = g.K, nt = K / BK;
    unsigned voffA[2], voffB[2];
#pragma unroll
    for (int i = 0; i < 2; ++i) { int R, C; stage_rc(tid * 16 + i * 8192, R, C); const int Rb = (R & ~31) + perm32(R & 31);
        voffA[i] = (unsigned)(R * g.lda + C) * 2u; voffB[i] = (unsigned)(Rb * g.ldb + C) * 2u; }
    const size_t kstep = (size_t)(BK * 2);
    const size_t hstepA = (size_t)HALF * g.lda * 2, hstepB = (size_t)HALF * g.ldb * 2;
    const size_t tstepA = 2 * hstepA, tstepB = 2 * hstepB;
    const unsigned ldsw = (unsigned)wid * 1024u;
    const int aoff = lds_byte(wr * 64 + fr, fq * 8), boff = lds_byte(wc * 32 + fr, fq * 8);
#define PG8_SA(b, h) (((b) * 2 + (h)) * HTB)
#define PG8_SB(b, h) ((4 + (b) * 2 + (h)) * HTB)
#define PG8_STAGE(bufoff, gbase, voff) do { _Pragma("unroll") for (int _i = 0; _i < 2; ++_i) \
        __builtin_amdgcn_global_load_lds((const unsigned*)((const char*)(gbase) + (voff)[_i]), (LAS unsigned*)(lds + (bufoff) + ldsw + _i * 8192), 16, 0, 0); } while (0)
#define PG8_LDA(dst, b, h) do { _Pragma("unroll") for (int m = 0; m < 4; ++m) _Pragma("unroll") for (int k = 0; k < 2; ++k) dst[m][k] = *(const LAS bf16x8*)(lds + PG8_SA(b, h) + aoff + m * 2048 + k * 1024); } while (0)
#define PG8_LDB(dst, b, h) do { _Pragma("unroll") for (int n = 0; n < 2; ++n) _Pragma("unroll") for (int k = 0; k < 2; ++k) dst[n][k] = *(const LAS bf16x8*)(lds + PG8_SB(b, h) + boff + n * 2048 + k * 1024); } while (0)
#define PG8_MMA(ai, bj, At, Bt) do { __builtin_amdgcn_s_setprio(1); _Pragma("unroll") for (int m = 0; m < 4; ++m) _Pragma("unroll") for (int n = 0; n < 2; ++n) _Pragma("unroll") for (int k = 0; k < 2; ++k) \
        acc[ai][bj][m][n] = __builtin_amdgcn_mfma_f32_16x16x32_bf16(Bt[n][k], At[m][k], acc[ai][bj][m][n], 0, 0, 0); __builtin_amdgcn_s_setprio(0); } while (0)
#define PG8_WAIT_V(n) asm volatile("s_waitcnt vmcnt(" #n ")" ::: "memory")
#define PG8_WAIT_L(n) asm volatile("s_waitcnt lgkmcnt(" #n ")" ::: "memory")
#define PG8_BAR __builtin_amdgcn_s_barrier()
#define PG8_SCHED __builtin_amdgcn_sched_barrier(0)
    Unit cur, nxt; int ui = 0;
    if (!S.next(0, cur)) return;
    f32x4 acc[2][2][4][2];
#pragma unroll
    for (int a = 0; a < 2; ++a)
#pragma unroll
        for (int b = 0; b < 2; ++b)
#pragma unroll
            for (int m = 0; m < 4; ++m)
#pragma unroll
                for (int n = 0; n < 2; ++n) acc[a][b][m][n] = (f32x4){0.f, 0.f, 0.f, 0.f};
    bf16x8 At[4][2], B0[2][2], B1[2][2];
    const char* cA = (const char*)g.A + (size_t)cur.pm * tstepA; const char* cB = (const char*)g.Bt + (size_t)cur.pn * tstepB;
    PG8_STAGE(PG8_SB(0, 0), cB, voffB); PG8_STAGE(PG8_SB(0, 1), cB + hstepB, voffB); PG8_STAGE(PG8_SA(0, 0), cA, voffA); PG8_STAGE(PG8_SA(0, 1), cA + hstepA, voffA);
    if (wr == 1) PG8_BAR;
    PG8_WAIT_V(2); PG8_BAR;
    PG8_STAGE(PG8_SB(1, 0), cB + kstep, voffB); PG8_STAGE(PG8_SA(1, 0), cA + kstep, voffA); PG8_STAGE(PG8_SB(1, 1), cB + hstepB + kstep, voffB);
    PG8_WAIT_V(6); PG8_BAR;
    for (;;) {
        const bool has_next = S.next(ui + 1, nxt);
        const char* nA = has_next ? (const char*)g.A + (size_t)nxt.pm * tstepA : cA; const char* nB = has_next ? (const char*)g.Bt + (size_t)nxt.pn * tstepB : cB;
#pragma unroll 1
        for (int t = 0; t < nt; t += 2) {
            const bool last = (t == nt - 2);
            const char* a1 = cA + (size_t)(t + 1) * kstep;
            const char* a2 = last ? nA : cA + (size_t)(t + 2) * kstep; const char* b2 = last ? nB : cB + (size_t)(t + 2) * kstep;
            const char* a3 = a2 + kstep; const char* b3 = b2 + kstep;
            if constexpr (HOOK) { if (t == 16 || t == 24) E.hook(acc, ui, t, wr, fr); }
            PG8_LDB(B0, 0, 0); PG8_LDB(B1, 0, 1); PG8_SCHED; PG8_LDA(At, 0, 0); PG8_STAGE(PG8_SA(1, 1), a1 + hstepA, voffA);
            PG8_WAIT_V(8); PG8_WAIT_L(0); PG8_BAR; PG8_MMA(0, 0, At, B0); PG8_MMA(0, 1, At, B1); PG8_BAR; PG8_SCHED;
            PG8_LDA(At, 0, 1); PG8_STAGE(PG8_SB(0, 0), b2, voffB); PG8_STAGE(PG8_SB(0, 1), b2 + hstepB, voffB); PG8_STAGE(PG8_SA(0, 0), a2, voffA);
            PG8_WAIT_V(8); PG8_WAIT_L(0); PG8_BAR; PG8_MMA(1, 0, At, B0); PG8_MMA(1, 1, At, B1); PG8_BAR; PG8_SCHED;
            PG8_LDB(B0, 1, 0); PG8_LDB(B1, 1, 1); PG8_SCHED; PG8_LDA(At, 1, 0); PG8_STAGE(PG8_SA(0, 1), a2 + hstepA, voffA);
            PG8_WAIT_V(8); PG8_WAIT_L(0); PG8_BAR; PG8_MMA(0, 0, At, B0); PG8_MMA(0, 1, At, B1); PG8_BAR; PG8_SCHED;
            PG8_LDA(At, 1, 1); PG8_STAGE(PG8_SB(1, 0), b3, voffB); PG8_STAGE(PG8_SB(1, 1), b3 + hstepB, voffB); PG8_STAGE(PG8_SA(1, 0), a3, voffA);
            PG8_WAIT_V(8); PG8_WAIT_L(0); PG8_BAR; PG8_MMA(1, 0, At, B0); PG8_MMA(1, 1, At, B1); PG8_BAR; PG8_SCHED;
        }
        if (wr == 0) PG8_BAR;
        E(acc, cur, ui, wr, wc, fr, fq);
        if (!has_next) break;
#pragma unroll
        for (int a = 0; a < 2; ++a)
#pragma unroll
            for (int b = 0; b < 2; ++b)
#pragma unroll
                for (int m = 0; m < 4; ++m)
#pragma unroll
                    for (int n = 0; n < 2; ++n) acc[a][b][m][n] = (f32x4){0.f, 0.f, 0.f, 0.f};
        cur = nxt; cA = nA; cB = nB; ++ui;
        if (wr == 1) PG8_BAR;
    }
    PG8_WAIT_V(0);
    PG8_BAR;
#undef PG8_SA
#undef PG8_SB
#undef PG8_STAGE
#undef PG8_LDA
#undef PG8_LDB
#undef PG8_MMA
#undef PG8_WAIT_V
#undef PG8_WAIT_L
#undef PG8_BAR
#undef PG8_SCHED
}
}
using pg8::Unit;

DI void rope4(f32x4& v0, f32x4& v1, const f32x4 cs0, const f32x4 cs1) {
    f32x4 a = v0, b = v1;
    v0[0] = a[0] * cs0[0] - a[1] * cs0[1]; v0[1] = a[1] * cs0[0] + a[0] * cs0[1];
    v0[2] = a[2] * cs0[2] - a[3] * cs0[3]; v0[3] = a[3] * cs0[2] + a[2] * cs0[3];
    v1[0] = b[0] * cs1[0] - b[1] * cs1[1]; v1[1] = b[1] * cs1[0] + b[0] * cs1[1];
    v1[2] = b[2] * cs1[2] - b[3] * cs1[3]; v1[3] = b[3] * cs1[2] + b[2] * cs1[3];
}
DI void store8(bf16_t* p, const f32x4 v0, const f32x4 v1) {
    u32x4 w; w.x = cvtpk(v0[0], v0[1]); w.y = cvtpk(v0[2], v0[3]); w.z = cvtpk(v1[0], v1[1]); w.w = cvtpk(v1[2], v1[3]);
    *(u32x4*)p = w;
}

struct EpiProj {
    bf16_t* O; bf16_t* QH; bf16_t* KR; const float* ropeA; const float* ropeB; float* ssqq; float* ssqkv;
    DI void hook(f32x4 (&)[2][2][4][2], int, int, int, int) const {}
    DI void operator()(const f32x4 (&acc)[2][2][4][2], const Unit& u, int ui, int wr, int wc, int fr, int fq) const {
        const int row0 = u.pm * 256 + wr * 64 + fr, col0 = u.pn * 256 + wc * 32 + 8 * fq;
        const bool rA = (u.pn < 8) && ((wc & 1) == 0) && (fq < 2);
        const bool rB = (u.pn == 23) && (wc == 0);
        const bool sq = (u.pn >= 22);
#pragma unroll
        for (int ai = 0; ai < 2; ++ai)
#pragma unroll
            for (int m = 0; m < 4; ++m) {
                const int row = row0 + ai * 128 + m * 16;
                f32x4 ca0, ca1, cb0, cb1;
                if (rA) { ca0 = *(const f32x4*)(ropeA + (size_t)row * 16 + 8 * fq); ca1 = *(const f32x4*)(ropeA + (size_t)row * 16 + 8 * fq + 4); }
                if (rB) { cb0 = *(const f32x4*)(ropeB + (size_t)row * 32 + 8 * fq); cb1 = *(const f32x4*)(ropeB + (size_t)row * 32 + 8 * fq + 4); }
                float s0 = 0.f, s1 = 0.f;
#pragma unroll
                for (int bj = 0; bj < 2; ++bj) {
                    f32x4 v0 = acc[ai][bj][m][0], v1 = acc[ai][bj][m][1];
                    const float q = (v0[0] * v0[0] + v0[1] * v0[1]) + (v0[2] * v0[2] + v0[3] * v0[3]) + (v1[0] * v1[0] + v1[1] * v1[1]) + (v1[2] * v1[2] + v1[3] * v1[3]);
                    if (bj == 0) s0 = q; else s1 = q;
                    if (rA) rope4(v0, v1, ca0, ca1);
                    if (rB && bj == 1) rope4(v0, v1, cb0, cb1);
                    if (u.pn < 12) {
                        const int head = (u.pn & 3) * 4 + bj * 2 + (wc >> 1), dim = (wc & 1) * 32 + 8 * fq, bb = row / SEQ, ss = row - bb * SEQ;
                        store8(QH + (size_t)(u.pn >> 2) * ((size_t)T * 1024) + ((size_t)(bb * 16 + head) * SEQ + ss) * 64 + dim, v0, v1);
                    } else if (rB && bj == 1) store8(KR + (size_t)row * 32 + 8 * fq, v0, v1);
                    else store8(O + (size_t)row * NP + (col0 - WOFF) + bj * 128, v0, v1);
                }
                if (sq) {
                    float s = (u.pn == 22) ? (s0 + s1) : s0;
                    s += __shfl_xor(s, 16); s += __shfl_xor(s, 32);
                    if (fq == 0) { float* d = (u.pn == 22) ? ssqq : ssqkv; d[(size_t)row * 4 + wc] = s; }
                }
            }
    }
};
struct EpiQ {
    bf16_t* O; const float* ropeB; const float* ssqq;
    DI void hook(f32x4 (&)[2][2][4][2], int, int, int, int) const {}
    DI void operator()(const f32x4 (&acc)[2][2][4][2], const Unit& u, int ui, int wr, int wc, int fr, int fq) const {
        const int row0 = u.pm * 256 + wr * 64 + fr, col0 = u.pn * 256 + wc * 32 + 8 * fq;
#pragma unroll
        for (int ai = 0; ai < 2; ++ai)
#pragma unroll
            for (int m = 0; m < 4; ++m) {
                const int row = row0 + ai * 128 + m * 16;
                const f32x4 sq = *(const f32x4*)(ssqq + (size_t)row * 4);
                const float rs = __builtin_amdgcn_rsqf(((sq[0] + sq[1]) + (sq[2] + sq[3])) * (1.0f / 256.0f) + EPS);
#pragma unroll
                for (int bj = 0; bj < 2; ++bj) {
                    f32x4 v0 = acc[ai][bj][m][0] * rs, v1 = acc[ai][bj][m][1] * rs;
                    const int cg0 = u.pn * 256 + bj * 128 + wc * 32;
                    if ((cg0 % 96) == 64) { const f32x4 cb0 = *(const f32x4*)(ropeB + (size_t)row * 32 + 8 * fq), cb1 = *(const f32x4*)(ropeB + (size_t)row * 32 + 8 * fq + 4); rope4(v0, v1, cb0, cb1); }
                    store8(O + (size_t)row * 768 + col0 + bj * 128, v0, v1);
                }
                asm volatile("" ::: "memory");
            }
    }
};
struct EpiKV {
    bf16_t* O; const float* ssqkv;
    DI void hook(f32x4 (&)[2][2][4][2], int, int, int, int) const {}
    DI void operator()(const f32x4 (&acc)[2][2][4][2], const Unit& u, int ui, int wr, int wc, int fr, int fq) const {
        const int row0 = u.pm * 256 + wr * 64 + fr, col0 = u.pn * 256 + wc * 32 + 8 * fq;
#pragma unroll
        for (int ai = 0; ai < 2; ++ai)
#pragma unroll
            for (int m = 0; m < 4; ++m) {
                const int row = row0 + ai * 128 + m * 16;
                const f32x4 sq = *(const f32x4*)(ssqkv + (size_t)row * 4);
                const float rs = __builtin_amdgcn_rsqf(((sq[0] + sq[1]) + (sq[2] + sq[3])) * (1.0f / 128.0f) + EPS);
                const int bb = row / SEQ, ss = row - bb * SEQ;
#pragma unroll
                for (int bj = 0; bj < 2; ++bj) store8(O + ((size_t)(bb * 8 + 2 * u.pn + bj) * SEQ + ss) * 128 + wc * 32 + 8 * fq, acc[ai][bj][m][0] * rs, acc[ai][bj][m][1] * rs);
                asm volatile("" ::: "memory");
            }
    }
};
struct EpiPlain {
    bf16_t* O; int ldc;
    DI void hook(f32x4 (&)[2][2][4][2], int, int, int, int) const {}
    DI void operator()(const f32x4 (&acc)[2][2][4][2], const Unit& u, int ui, int wr, int wc, int fr, int fq) const {
        const int row0 = u.pm * 256 + wr * 64 + fr, col0 = u.pn * 256 + wc * 32 + 8 * fq;
#pragma unroll
        for (int ai = 0; ai < 2; ++ai)
#pragma unroll
            for (int m = 0; m < 4; ++m) {
                const int row = row0 + ai * 128 + m * 16;
#pragma unroll
                for (int bj = 0; bj < 2; ++bj) store8(O + (size_t)row * ldc + col0 + bj * 128, acc[ai][bj][m][0], acc[ai][bj][m][1]);
            }
    }
};
struct EpiOut {
    bf16_t* stage; const bf16_t* hb; float* pstat;
    const LAS f32x4* rtab;
    DI void hook(f32x4 (&acc)[2][2][4][2], int ui, int t, int wr, int fr) const {
#pragma unroll
        for (int ai = 0; ai < 2; ++ai)
#pragma unroll
            for (int m = 0; m < 4; ++m) {
                const f32x4 r = rtab[ui * 256 + ai * 128 + wr * 64 + m * 16 + fr];
                const float f = (t == 16) ? r[0] : r[1];
#pragma unroll
                for (int bj = 0; bj < 2; ++bj) { acc[ai][bj][m][0] = acc[ai][bj][m][0] * f; acc[ai][bj][m][1] = acc[ai][bj][m][1] * f; }
            }
    }
    DI void operator()(const f32x4 (&acc)[2][2][4][2], const Unit& u, int ui, int wr, int wc, int fr, int fq) const {
        const int col0 = u.pn * 256 + wc * 32 + 8 * fq;
#pragma unroll
        for (int ai = 0; ai < 2; ++ai)
#pragma unroll
            for (int m = 0; m < 4; ++m) {
                const int rl = ai * 128 + wr * 64 + m * 16 + fr, row = u.pm * 256 + rl;
                const float rsm = rtab[ui * 256 + rl][2];
                float s = 0.f, q = 0.f;
#pragma unroll
                for (int bj = 0; bj < 2; ++bj) {
                    const u32x4 hw = *(const u32x4*)(hb + (size_t)row * DM + col0 + bj * 128);
                    const f32x4 h0 = {__builtin_bit_cast(float, hw.x << 16), __builtin_bit_cast(float, hw.x & 0xffff0000u), __builtin_bit_cast(float, hw.y << 16), __builtin_bit_cast(float, hw.y & 0xffff0000u)};
                    const f32x4 h1 = {__builtin_bit_cast(float, hw.z << 16), __builtin_bit_cast(float, hw.z & 0xffff0000u), __builtin_bit_cast(float, hw.w << 16), __builtin_bit_cast(float, hw.w & 0xffff0000u)};
                    const f32x4 v0 = acc[ai][bj][m][0] * rsm + h0 * ALPHA, v1 = acc[ai][bj][m][1] * rsm + h1 * ALPHA;
                    store8(stage + (size_t)row * DM + col0 + bj * 128, v0, v1);
                    s += ((v0[0] + v0[1]) + (v0[2] + v0[3])) + ((v1[0] + v1[1]) + (v1[2] + v1[3]));
                    q += ((v0[0] * v0[0] + v0[1] * v0[1]) + (v0[2] * v0[2] + v0[3] * v0[3])) + ((v1[0] * v1[0] + v1[1] * v1[1]) + (v1[2] * v1[2] + v1[3] * v1[3]));
                }
                s += __shfl_xor(s, 16); s += __shfl_xor(s, 32); q += __shfl_xor(q, 16); q += __shfl_xor(q, 32);
                if (fq == 0) *(f32x2*)(pstat + ((size_t)row * 16 + u.pn * 4 + wc) * 2) = (f32x2){s, q};
            }
    }
};

DI float xhalf_max(float x) { float a = x, b = x; asm volatile("s_nop 1\n\tv_permlane32_swap_b32 %0, %1" : "+v"(a), "+v"(b)); return fmaxf(a, b); }
#define MFMA32(a, b, c) __builtin_amdgcn_mfma_f32_32x32x16_bf16((a), (b), (c), 0, 0, 0)
DI int crow(int reg, int h) { return (reg & 3) + 8 * (reg >> 2) + 4 * h; }
DI s16x4 vtr(const LAS char* p) { return __builtin_bit_cast(s16x4, __builtin_amdgcn_ds_read_tr16_b64_v4i16((LAS s16x4*)p)); }
DI bf16x8 pack8(const f32x16& x, int s) {
    u32x4 p; p.x = cvtpk(x[8 * s], x[8 * s + 1]); p.y = cvtpk(x[8 * s + 2], x[8 * s + 3]); p.z = cvtpk(x[8 * s + 4], x[8 * s + 5]); p.w = cvtpk(x[8 * s + 6], x[8 * s + 7]);
    return __builtin_bit_cast(bf16x8, p);
}
DI float max16(const f32x16& s) {
    float a = fmaxf(fmaxf(s[0], s[1]), fmaxf(s[2], s[3])), b = fmaxf(fmaxf(s[4], s[5]), fmaxf(s[6], s[7]));
    float c = fmaxf(fmaxf(s[8], s[9]), fmaxf(s[10], s[11])), d = fmaxf(fmaxf(s[12], s[13]), fmaxf(s[14], s[15]));
    return fmaxf(fmaxf(a, b), fmaxf(c, d));
}


template <int DV>
DI void epi_rows(LAS float* buf, const f32x16* o, float inv, bf16_t* gy0  , int gp, float* ssq0, int lane) {
    constexpr int P = DV + 4, CH = DV / 8, RPI = 64 / CH, NIT = 32 / RPI;
    const int r32 = lane & 31, h = lane >> 5;
#pragma unroll
    for (int d = 0; d < DV / 32; ++d)
#pragma unroll
        for (int g = 0; g < 4; ++g) *(LAS f32x4*)(buf + r32 * P + 32 * d + 8 * g + 4 * h) = (f32x4){o[d][4 * g] * inv, o[d][4 * g + 1] * inv, o[d][4 * g + 2] * inv, o[d][4 * g + 3] * inv};
    asm volatile("" ::: "memory");
    const int c = lane % CH, q0 = lane / CH;
#pragma unroll
    for (int i = 0; i < NIT; ++i) {
        const int q = q0 + RPI * i;
        const f32x4 a0 = *(const LAS f32x4*)(buf + q * P + 8 * c), a1 = *(const LAS f32x4*)(buf + q * P + 8 * c + 4);
        bf16_t* gy = gy0 + (size_t)q * gp + 8 * c;
        const u32x4 gw = *(const u32x4*)gy;
        float sq = (a0[0] * a0[0] + a0[1] * a0[1]) + (a0[2] * a0[2] + a0[3] * a0[3]) + (a1[0] * a1[0] + a1[1] * a1[1]) + (a1[2] * a1[2] + a1[3] * a1[3]);
#pragma unroll
        for (int m = 1; m < CH; m <<= 1) sq += __shfl_xor(sq, m);
        u32x4 ow;
        ow.x = cvtpk(a0[0] * silu(__builtin_bit_cast(float, gw.x << 16)), a0[1] * silu(__builtin_bit_cast(float, gw.x & 0xffff0000u)));
        ow.y = cvtpk(a0[2] * silu(__builtin_bit_cast(float, gw.y << 16)), a0[3] * silu(__builtin_bit_cast(float, gw.y & 0xffff0000u)));
        ow.z = cvtpk(a1[0] * silu(__builtin_bit_cast(float, gw.z << 16)), a1[1] * silu(__builtin_bit_cast(float, gw.z & 0xffff0000u)));
        ow.w = cvtpk(a1[2] * silu(__builtin_bit_cast(float, gw.w << 16)), a1[3] * silu(__builtin_bit_cast(float, gw.w & 0xffff0000u)));
        *(u32x4*)gy = ow;
        if (c == 0) ssq0[(size_t)q * 32] = sq;
    }
    asm volatile("" ::: "memory");
}

template <int DQK, int D1, int DV, int QT>
DI void attn_dense_unit(LAS char* lds, const bf16_t* q, int qp, const bf16_t* k1, int k1p, const bf16_t* k2, int k2p, const bf16_t* v, int vp, int nkeys,
                        bf16_t* gate_y, int gp, float* ssq  ) {
    constexpr int KP = DQK * 2 + 16, VP = DV * 2 + (DV == 64 ? 16 : 32);
    constexpr int KT = 64 * KP, VT = 64 * VP, BUF = KT + VT;
    constexpr int KCH = DQK / 8, VCH = DV / 8, NKC = 64 * KCH, NVC = 64 * VCH;
    constexpr int KI = (NKC + NTHREADS - 1) / NTHREADS, VI = (NVC + NTHREADS - 1) / NTHREADS;
    constexpr int NKS = DQK / 16, NDT = DV / 32;
    int tid_ = threadIdx.x; asm volatile("" : "+v"(tid_));
    const int tid = tid_, lane = tid & 63, w = __builtin_amdgcn_readfirstlane(tid >> 6), r32 = lane & 31, h = lane >> 5;
    bf16x8 qf[QT][NKS];
#pragma unroll
    for (int qt = 0; qt < QT; ++qt) { const bf16_t* qr = q + (size_t)((w * QT + qt) * 32 + r32) * qp + 8 * h;
#pragma unroll
      for (int s = 0; s < NKS; ++s) qf[qt][s] = *(const bf16x8*)(qr + 16 * s); }
    u32x4 kreg[KI], vreg[VI];
    auto load_regs = [&](int t) {
#pragma unroll
        for (int i = 0; i < KI; ++i) { const int c = tid + i * NTHREADS; if (NKC % NTHREADS == 0 || c < NKC) { const int r = c / KCH, j = c % KCH; const size_t row = (size_t)(t * 64 + r);
            kreg[i] = (j * 8 < D1) ? *(const u32x4*)(k1 + row * k1p + j * 8) : *(const u32x4*)(k2 + row * k2p + (j * 8 - D1)); } }
#pragma unroll
        for (int i = 0; i < VI; ++i) { const int c = tid + i * NTHREADS; if (NVC % NTHREADS == 0 || c < NVC) { const int r = c / VCH, j = c % VCH; vreg[i] = *(const u32x4*)(v + (size_t)(t * 64 + r) * vp + j * 8); } }
    };
    auto store_lds = [&](int b) {
        LAS char* kb = lds + b * BUF; LAS char* vb = kb + KT;
#pragma unroll
        for (int i = 0; i < KI; ++i) { const int c = tid + i * NTHREADS; if (NKC % NTHREADS == 0 || c < NKC) { const int r = c / KCH, j = c % KCH; *(LAS u32x4*)(kb + r * KP + j * 16) = kreg[i]; } }
#pragma unroll
        for (int i = 0; i < VI; ++i) { const int c = tid + i * NTHREADS; if (NVC % NTHREADS == 0 || c < NVC) { const int r = c / VCH, j = c % VCH; *(LAS u32x4*)(vb + r * VP + j * 16) = vreg[i]; } }
    };
    f32x16 o[QT][NDT]; float mrun[QT], lrun[QT];
#pragma unroll
    for (int qt = 0; qt < QT; ++qt) { mrun[qt] = NEGBIG; lrun[qt] = 0.f;
#pragma unroll
        for (int d = 0; d < NDT; ++d)
#pragma unroll
            for (int i = 0; i < 16; ++i) o[qt][d][i] = 0.f; }
    const int i16 = lane & 15, tq = i16 >> 2, tp = i16 & 3, blk = (lane >> 4) & 1;
    const int voff = (4 * h + tq) * VP + (16 * blk + 4 * tp) * 2;
    const int NT = nkeys / 64;
    load_regs(0); store_lds(0);
#pragma unroll
    for (int qt = 0; qt < QT; ++qt)
#pragma unroll
        for (int s = 0; s < NKS; ++s) asm volatile("" : "+v"(qf[qt][s]));
    __syncthreads();
    for (int t = 0; t < NT; ++t) {
        if (t + 1 < NT) load_regs(t + 1);
        const LAS char* kb = lds + (t & 1) * BUF; const LAS char* vb = kb + KT;
#pragma unroll
        for (int sub = 0; sub < 2; ++sub) {
            f32x16 sc[QT];
#pragma unroll
            for (int qt = 0; qt < QT; ++qt)
#pragma unroll
                for (int i = 0; i < 16; ++i) sc[qt][i] = 0.f;
            __builtin_amdgcn_s_setprio(1);
#pragma unroll
            for (int s = 0; s < NKS; ++s) {
                const bf16x8 a0 = *(const LAS bf16x8*)(kb + (32 * sub + r32) * KP + (16 * s + 8 * h) * 2);
#pragma unroll
                for (int qt = 0; qt < QT; ++qt) sc[qt] = MFMA32(a0, qf[qt][s], sc[qt]);
            }
            __builtin_amdgcn_s_setprio(0);
            bf16x8 pb[QT][2];
#pragma unroll
            for (int qt = 0; qt < QT; ++qt) {
                float mx = max16(sc[qt]); mx = xhalf_max(mx);
                const float mnew = fmaxf(mrun[qt], mx);
                if (__builtin_amdgcn_ballot_w64(mnew > mrun[qt]) != 0ull) {
                    const float alpha = fast_exp2(mrun[qt] - mnew); lrun[qt] = lrun[qt] * alpha;
#pragma unroll
                    for (int d = 0; d < NDT; ++d) o[qt][d] = o[qt][d] * alpha;
                }
                mrun[qt] = mnew;
                float rs = 0.f;
#pragma unroll
                for (int i = 0; i < 16; ++i) { sc[qt][i] = fast_exp2(sc[qt][i] - mnew); rs += sc[qt][i]; }
                lrun[qt] = lrun[qt] + rs;
                pb[qt][0] = pack8(sc[qt], 0); pb[qt][1] = pack8(sc[qt], 1);
            }
#pragma unroll
            for (int ks = 0; ks < 2; ++ks) {
                const LAS char* vr = vb + voff + (32 * sub + 16 * ks) * VP;
#pragma unroll
                for (int d = 0; d < NDT; ++d) {
                    const s16x4 lo = vtr(vr + d * 64), hi = vtr(vr + 8 * VP + d * 64);
                    const bf16x8 va = __builtin_shufflevector(lo, hi, 0, 1, 2, 3, 4, 5, 6, 7);
#pragma unroll
                    for (int qt = 0; qt < QT; ++qt) o[qt][d] = MFMA32(va, pb[qt][ks], o[qt][d]);
                }
            }
        }
        if (t + 1 < NT) store_lds((t + 1) & 1);
        __syncthreads();
    }
#pragma unroll
    for (int qt = 0; qt < QT; ++qt) {
        const float ltot = lrun[qt] + __shfl_xor(lrun[qt], 32), inv = 1.0f / ltot;
        const int row0 = (w * QT + qt) * 32;
        epi_rows<DV>((LAS float*)(lds + w * (32 * (DV + 4) * 4)), o[qt], inv, gate_y + (size_t)row0 * gp, gp, ssq + (size_t)row0 * 32, lane);
    }
    __syncthreads();
}

constexpr int A_OSTP = 64;
DI int a_swz(int row, int chunk) { return ((chunk ^ row ^ (row >> 4)) & 15) * 4; }
constexpr int A_VP = 144, A_VWB = 2 * 32 * A_VP, A_VW_OFF = 0, A_ST_OFF = 8 * A_VWB, A_ML_OFF = A_ST_OFF + 512 * 128;
DI int st_swz(int row, int chunk) { return ((chunk ^ row ^ (row >> 4)) & 15) * 8; }
struct AHead { const bf16_t* q; const bf16_t* k; const bf16_t* v; bf16_t* gate; };
struct APf { u32x4 kc[4], vc[4]; bf16x8 qf[4]; };
template <int DIL> DI void a_geom(int P0, int w, int r32, int& qpos, int& kb0) {
    if (DIL == 16) { qpos = P0 + w + 16 * r32; kb0 = w; }
    else if (DIL == 4) { const int base = P0 + 128 * (w >> 2) + (w & 3); qpos = base + 4 * r32; kb0 = base - 256; }
    else { const int base = P0 + 32 * w; qpos = base + r32; kb0 = base - 64; }
}
template <int DIL> DI int a_kbase(int w, int kb0, int i) { return kb0 + DIL * 32 * i; }
DI int a_clamp(int p) { return p < 0 ? 0 : (p > SEQ - 1 ? SEQ - 1 : p); }
template <int DIL> DI void a_issue_kv(APf& pf, const AHead& hp, int kb, int lane) {
    const int kbs = __builtin_amdgcn_readfirstlane(((unsigned)kb < (unsigned)SEQ) ? kb : 0);
    const char* sbk = (const char*)(hp.k + (size_t)kbs * 64); const char* sbv = (const char*)(hp.v + (size_t)kbs * 64);
#pragma unroll
    for (int j = 0; j < 4; ++j) { const int c = lane + 64 * j, r = c >> 3, ch = c & 7; const unsigned vo = (unsigned)(DIL * r * 64 + 8 * ch) * 2u;
        pf.kc[j] = *(const u32x4*)(sbk + vo); pf.vc[j] = *(const u32x4*)(sbv + vo); }
}
template <int DIL> DI void a_first_issue(APf& pf, const AHead& hp, int P0, int w, int lane) {
    const int r32 = lane & 31, h = lane >> 5; int qpos, kb0; a_geom<DIL>(P0, w, r32, qpos, kb0);
    const bf16_t* qr = hp.q + (size_t)qpos * 64 + 8 * h;
#pragma unroll
    for (int s = 0; s < 4; ++s) pf.qf[s] = *(const bf16x8*)(qr + 16 * s);
    a_issue_kv<DIL>(pf, hp, a_kbase<DIL>(w, kb0, 0), lane);
}
template <int DIL, int PASS, class NextFn>
DI void attnA_pass(LAS char* lds, const AHead& hp, float* ssq  , int P0, int w, int lane_, APf& pf, NextFn next_issue) {
    int lane = lane_; asm volatile("" : "+v"(lane));
    const int r32 = lane & 31, h = lane >> 5;
    int qpos, kb0; constexpr int NSUB = (DIL == 16) ? 4 : 5;
    a_geom<DIL>(P0, w, r32, qpos, kb0);
    const int qloc = qpos - P0;
    LAS char* stt = lds + A_ST_OFF; LAS float* ml = (LAS float*)(lds + A_ML_OFF); LAS char* vw = lds + A_VW_OFF + (w & 7) * A_VWB;
    f32x16 o[2]; float mrun, lrun;
    if (PASS == 0) {
#pragma unroll
        for (int d = 0; d < 2; ++d)
#pragma unroll
            for (int i = 0; i < 16; ++i) o[d][i] = 0.f;
        mrun = NEGBIG; lrun = 0.f;
    } else {
#pragma unroll
        for (int d = 0; d < 2; ++d)
#pragma unroll
            for (int g = 0; g < 4; ++g) { const u32x2 t2 = *(const LAS u32x2*)(stt + qloc * 128 + st_swz(qloc, 8 * d + 2 * g + h));
                o[d][4 * g] = __builtin_bit_cast(float, t2.x << 16); o[d][4 * g + 1] = __builtin_bit_cast(float, t2.x & 0xffff0000u); o[d][4 * g + 2] = __builtin_bit_cast(float, t2.y << 16); o[d][4 * g + 3] = __builtin_bit_cast(float, t2.y & 0xffff0000u); }
        const f32x2 mlv = *(const LAS f32x2*)(ml + qloc * 2); mrun = mlv[0]; lrun = (h == 0) ? mlv[1] : 0.f;
    }
    auto kbase_of = [&](int i) -> int { return a_kbase<DIL>(w, kb0, i); };
    LAS char* kw = vw; LAS char* vw2 = vw + 32 * A_VP;
    auto issue = [&](int i) { a_issue_kv<DIL>(pf, hp, kbase_of(i), lane); };
    auto vstore = [&]() {
#pragma unroll
        for (int j = 0; j < 4; ++j) { const int c = lane + 64 * j, r = c >> 3, ch = c & 7; *(LAS u32x4*)(kw + r * A_VP + ch * 16) = pf.kc[j]; *(LAS u32x4*)(vw2 + r * A_VP + ch * 16) = pf.vc[j]; }
        asm volatile("" ::: "memory");
    };
    const int i16 = lane & 15, tq = i16 >> 2, tp = i16 & 3, blk = (lane >> 4) & 1;
    const int voff = (4 * h + tq) * A_VP + (16 * blk + 4 * tp) * 2;
    const int koff = r32 * A_VP + 16 * h;
    APf pb2;
    a_issue_kv<DIL>(pb2, hp, kbase_of(1), lane);
    auto vstoreB = [&]() {
#pragma unroll
        for (int j = 0; j < 4; ++j) { const int c = lane + 64 * j, r = c >> 3, ch = c & 7; *(LAS u32x4*)(kw + r * A_VP + ch * 16) = pb2.kc[j]; *(LAS u32x4*)(vw2 + r * A_VP + ch * 16) = pb2.vc[j]; }
        asm volatile("" ::: "memory");
    };
    bf16x8 qf[4];
#pragma unroll
    for (int s = 0; s < 4; ++s) qf[s] = pf.qf[s];
    auto compute = [&](int i) {
        const int kb = kbase_of(i);
        bool live;
        if (DIL == 16) { const int t0 = 32 * i, q0 = P0 >> 4; live = (t0 + 31 >= q0 - 64) && (t0 <= q0 + 95); }
        else live = (unsigned)kb < (unsigned)SEQ;
        if (live) {
        f32x16 st;
#pragma unroll
        for (int j = 0; j < 16; ++j) st[j] = 0.f;
#pragma unroll
        for (int s = 0; s < 4; ++s) { const bf16x8 ka = *(const LAS bf16x8*)(kw + koff + 32 * s); st = MFMA32(ka, qf[s], st); }
        if (DIL == 16) {
            const int jq = (P0 >> 4) + r32;
            const int tt = 32 * i + 4 * h - jq + 64;
#pragma unroll
            for (int j = 0; j < 16; ++j) st[j] = ((unsigned)(tt + ((j & 3) + 8 * (j >> 2))) <= 128u) ? st[j] : NEGBIG;
        } else if (i == 0) {
#pragma unroll
            for (int j = 0; j < 16; ++j) st[j] = (crow(j, h) >= r32) ? st[j] : NEGBIG;
        } else if (i == 4) {
#pragma unroll
            for (int j = 0; j < 16; ++j) st[j] = (crow(j, h) <= r32) ? st[j] : NEGBIG;
        }
        float mx = max16(st); mx = xhalf_max(mx);
        const float mnew = fmaxf(mrun, mx);
        if (__builtin_amdgcn_ballot_w64(mnew > mrun) != 0ull) { const float alpha = fast_exp2(mrun - mnew); lrun = lrun * alpha; o[0] = o[0] * alpha; o[1] = o[1] * alpha; }
        mrun = mnew;
        float rs = 0.f;
#pragma unroll
        for (int j = 0; j < 16; ++j) { st[j] = fast_exp2(st[j] - mnew); rs += st[j]; }
        lrun = lrun + rs;
#pragma unroll
        for (int ks = 0; ks < 2; ++ks) {
            const bf16x8 pb = pack8(st, ks);
            const LAS char* vr = vw2 + voff + (16 * ks) * A_VP;
#pragma unroll
            for (int d = 0; d < 2; ++d) {
                const s16x4 lo = vtr(vr + d * 64), hi = vtr(vr + 8 * A_VP + d * 64);
                const bf16x8 va = __builtin_shufflevector(lo, hi, 0, 1, 2, 3, 4, 5, 6, 7);
                o[d] = MFMA32(va, pb, o[d]);
            }
        }
        }
        asm volatile("" ::: "memory");
    };
    vstore();
#pragma unroll
    for (int s = 0; s < 4; ++s) asm volatile("" : "+v"(qf[s]));
    if (2 < NSUB) issue(2);
    compute(0);
#pragma unroll 1
    for (int i = 1; i < NSUB; i += 2) {
        vstoreB(); if (i + 2 < NSUB) a_issue_kv<DIL>(pb2, hp, kbase_of(i + 2), lane); compute(i);
        if (i + 1 < NSUB) { vstore(); if (i + 3 < NSUB) issue(i + 3); compute(i + 1); }
    }
    next_issue();
    if (PASS < 2) {
#pragma unroll
        for (int d = 0; d < 2; ++d)
#pragma unroll
            for (int g = 0; g < 4; ++g) { u32x2 ow; ow.x = cvtpk(o[d][4 * g], o[d][4 * g + 1]); ow.y = cvtpk(o[d][4 * g + 2], o[d][4 * g + 3]); *(LAS u32x2*)(stt + qloc * 128 + st_swz(qloc, 8 * d + 2 * g + h)) = ow; }
        const float ltot = lrun + __shfl_xor(lrun, 32);
        if (h == 0) *(LAS f32x2*)(ml + qloc * 2) = (f32x2){mrun, ltot};
    } else {
        const float ltot = lrun + __shfl_xor(lrun, 32), inv = 1.0f / ltot;
        const int q0pos = qpos - r32;
        epi_rows<64>((LAS float*)vw, o, inv, hp.gate + (size_t)q0pos * NP, NP, ssq + (size_t)q0pos * 32, lane);
    }
}

DI int win_dst(int n, float& scale) {
    scale = 1.0f;
    if (n < 2048) { const int d = n & 63, base = n - d; if (n < 1024) scale = 0.125f * LOG2E; return base + (d < 16 ? ((d & 7) * 2 + (d >> 3)) : d); }
    if (n < 4096) return n;
    if (n < 4352) return WOFF + C_CQ + (n - 4096);
    if (n < 4480) return WOFF + C_CKV + (n - 4352);
    if (n < 4512) { const int d = n - 4480; return WOFF + C_KR + ((d & 15) * 2 + (d >> 4)); }
    if (n < 5024) return WOFF + C_BG + (n - 4512);
    if (n < 5536) { scale = 0.08838834764831845f * LOG2E; return WOFF + C_MQ + (n - 5024); }
    return WOFF + C_MG + (n - 5536);
}
template <int MODE>
DI void tr_item(const float* W, int K, int N, bf16_t* WT, const float* g0, const float* g1, const float* g2, LAS float* scr, int item, int lane) {
    const int nblk = N / 32, kb = item / nblk, nb = item % nblk, k0 = 64 * kb, n0 = 32 * nb;
    float wv[32];
#pragma unroll
    for (int i = 0; i < 32; ++i) { const int kk = 2 * i + (lane >> 5); wv[i] = W[(size_t)(k0 + kk) * N + n0 + (lane & 31)]; }
#pragma unroll
    for (int i = 0; i < 32; ++i) { const int kk = 2 * i + (lane >> 5); scr[kk * 33 + (lane & 31)] = wv[i]; }
    asm volatile("s_waitcnt lgkmcnt(0)" ::: "memory");
    const int c = lane & 7;
    float gk[8];
#pragma unroll
    for (int e = 0; e < 8; ++e) { const int k = k0 + 8 * c + e;
        if (MODE == 1 || MODE == 2) gk[e] = g0[k];
        else if (MODE == 4) gk[e] = (k < 1024) ? g0[k] : (k < 1536 ? g1[k - 1024] : g2[k - 1536]);
        else gk[e] = 1.0f; }
#pragma unroll
    for (int j = 0; j < 4; ++j) {
        const int nl = (lane >> 3) + 8 * j, n = n0 + nl; float sc = 1.0f; int dst = n;
        if (MODE == 0) dst = win_dst(n, sc);
        if (MODE == 1) { const int hd = n / 96, d = n % 96; sc = 0.10206207261596575f * LOG2E; if (d >= 64) { const int r = d - 64; dst = hd * 96 + 64 + ((r & 15) * 2 + (r >> 4)); } }
        const LAS float* s = scr + (8 * c) * 33 + nl;
        u32x4 o4; o4.x = cvtpk(s[0 * 33] * gk[0] * sc, s[1 * 33] * gk[1] * sc); o4.y = cvtpk(s[2 * 33] * gk[2] * sc, s[3 * 33] * gk[3] * sc);
        o4.z = cvtpk(s[4 * 33] * gk[4] * sc, s[5 * 33] * gk[5] * sc); o4.w = cvtpk(s[6 * 33] * gk[6] * sc, s[7 * 33] * gk[7] * sc);
        *(u32x4*)(WT + (size_t)dst * K + k0 + 8 * c) = o4;
    }
    asm volatile("s_waitcnt lgkmcnt(0)" ::: "memory");
}

__constant__ double INVF_A[8] = {1.0, 0.19390103887252767, 0.037597612875247145, 0.007290216193692821, 0.0014135804504232794, 0.00027409471785274054, 5.3147250536566735e-05, 1.0305307092165658e-05};
__constant__ double INVF_B[16] = {1.0, 0.44034195675670255, 0.19390103887252767, 0.08538276288621138, 0.037597612875247145, 0.016555806424970463, 0.007290216193692821, 0.0032101880639213203,
                                  0.0014135804504232794, 0.0006224587813827168, 0.00027409471785274054, 0.00012069540440475095, 5.3147250536566735e-05, 2.3402964294289857e-05, 1.0305307092165658e-05, 4.537859090181327e-06};


#define XB_TMO      128
#define XB_XCNT(j)  (256  + 64 * (j))
#define XB_XSUB(j)  (1280 + 64 * (j))
#define XB_XGEN(j)  (2304 + 64 * (j))
#define XB_TOP      3328
#define XB_TOPGEN   3392
#define XCD_BAR_WORDS 3456
#define XB_SPIN_CAP (1u << 18)
DI unsigned xb_ld(unsigned* p)              { return __hip_atomic_load(p, __ATOMIC_RELAXED, __HIP_MEMORY_SCOPE_AGENT); }
DI unsigned xb_add(unsigned* p, unsigned v) { return __hip_atomic_fetch_add(p, v, __ATOMIC_RELAXED, __HIP_MEMORY_SCOPE_AGENT); }
DI unsigned xb_xcc_id() { return (unsigned)__builtin_amdgcn_s_getreg((3 << 11) | 20) & 0xFu; }
#define XB_SPIN(cond, bar) do { unsigned _sp = 0; while (cond) { __builtin_amdgcn_s_sleep(1); \
    if ((++_sp & 255u) == 0u) { if (xb_ld(&(bar)[XB_TMO])) break; if (_sp > XB_SPIN_CAP) { atomicAdd(&(bar)[XB_TMO], 1u); break; } } } } while (0)
struct XcdBarrier { unsigned* bar; unsigned x; volatile LAS unsigned* st; };
DI XcdBarrier xcd_barrier_post(unsigned* bar, volatile LAS unsigned* st) {
    XcdBarrier b; b.bar = bar; b.x = xb_xcc_id(); b.st = st;
    if (threadIdx.x == 0) (void)xb_add(&bar[XB_XCNT(b.x)], 1u);
    return b;
}
DI void xcd_barrier_complete(unsigned* bar, unsigned x, unsigned& nloc, unsigned& nx) {
    const unsigned G = gridDim.x * gridDim.y * gridDim.z;
    unsigned sum, cnt, mine, sp = 0u;
    for (;;) {
        sum = 0u; cnt = 0u; mine = 0u;
#pragma unroll
        for (unsigned j = 0; j < 16; ++j) { const unsigned c = xb_ld(&bar[XB_XCNT(j)]); sum += c; cnt += (c > 0u) ? 1u : 0u; mine = (j == x) ? c : mine; }
        if (sum == G) break;
        __builtin_amdgcn_s_sleep(1);
        if ((++sp & 255u) == 0u) { if (xb_ld(&bar[XB_TMO])) break; if (sp > XB_SPIN_CAP) { atomicAdd(&bar[XB_TMO], 1u); break; } }
    }
    nloc = mine > 0u ? mine : 1u; nx = cnt > 0u ? cnt : 1u;
}
DI void xcd_barrier(const XcdBarrier& b) {
    asm volatile("s_waitcnt vmcnt(0)" ::: "memory");
    __syncthreads();
    if (threadIdx.x == 0) {
        unsigned* bar = b.bar;
        __builtin_amdgcn_s_waitcnt(0);
        unsigned nloc = b.st[0], nx = b.st[1];
        if (nloc == 0u) { xcd_barrier_complete(bar, b.x, nloc, nx); b.st[0] = nloc; b.st[1] = nx; }
        const unsigned old = xb_add(&bar[XB_XSUB(b.x)], 1u);
        const unsigned gen = old / nloc;
        if (old + 1u == (gen + 1u) * nloc) {
            __builtin_amdgcn_fence(__ATOMIC_RELEASE, "agent");
            asm volatile("s_waitcnt vmcnt(0)" ::: "memory");
            const unsigned og = xb_add(&bar[XB_TOP], 1u);
            const unsigned tg = og / nx;
            if (og + 1u == (tg + 1u) * nx) xb_add(&bar[XB_TOPGEN], 1u);
            else XB_SPIN(xb_ld(&bar[XB_TOPGEN]) == tg, bar);
            __builtin_amdgcn_fence(__ATOMIC_ACQUIRE, "agent");
            xb_add(&bar[XB_XGEN(b.x)], 1u);
            asm volatile("s_waitcnt vmcnt(0)" ::: "memory");
        } else {
            XB_SPIN(xb_ld(&bar[XB_XGEN(b.x)]) == gen, bar);
            __builtin_amdgcn_fence(__ATOMIC_ACQUIRE, "agent");
            asm volatile("s_waitcnt vmcnt(0)" ::: "memory");
        }
    }
    __syncthreads();
}

struct Args {
    const float* x; const float* mem; const int* pos; const float* g_emb; const float* b_emb; const float* w_in; const float* g_cq; const float* g_ckv;
    const float* w_uq; const float* w_ukv; const float* w_mem_kv; const float* g_out_a; const float* g_out_b; const float* g_out_m; const float* w_out;
    const float* g_post; const float* b_post; float* out; unsigned char* ws; int ph_lo, ph_hi;
};

__global__ void __launch_bounds__(NTHREADS, 2) fwd_mega(Args a) {
    extern __shared__ __attribute__((aligned(16))) unsigned char lds_raw[];
    LAS unsigned char* lds = (LAS unsigned char*)lds_raw;
    cg::grid_group grid = cg::this_grid();
    const int tid = threadIdx.x, lane = tid & 63, wave = __builtin_amdgcn_readfirstlane(tid >> 6);
    const int G = gridDim.x, bx = blockIdx.x;
    const int gw = bx * 8 + wave, NGW = G * 8;
    unsigned char* ws = a.ws;
    bf16_t* PROJ = (bf16_t*)(ws + WS_PROJ); bf16_t* QHB = (bf16_t*)(ws + WS_QH); bf16_t* KRB = (bf16_t*)(ws + WS_KR); bf16_t* KVB = (bf16_t*)(ws + WS_KVB); bf16_t* WIN = (bf16_t*)(ws + WS_WIN); bf16_t* WOUT = (bf16_t*)(ws + WS_WOUT);
    bf16_t* WMEM = (bf16_t*)(ws + WS_WMEM); bf16_t* WUQ = (bf16_t*)(ws + WS_WUQ); bf16_t* WUKV = (bf16_t*)(ws + WS_WUKV); bf16_t* MEMB = (bf16_t*)(ws + WS_MEMB);
    bf16_t* MKV = (bf16_t*)(ws + WS_MKV); float* ROPEA = (float*)(ws + WS_ROPEA); float* ROPEB = (float*)(ws + WS_ROPEB); float* XSTAT = (float*)(ws + WS_XSTAT);
    float* SSQQ = (float*)(ws + WS_SSQQ); float* SSQKV = (float*)(ws + WS_SSQKV); float* SSQY = (float*)(ws + WS_SSQY); float* PSTAT = (float*)(ws + WS_PSTAT);
    bf16_t* H = (bf16_t*)((unsigned char*)a.out + OUT_H); bf16_t* QB = (bf16_t*)((unsigned char*)a.out + OUT_QB);
    const int lo = a.ph_lo, hi = a.ph_hi;
    volatile LAS unsigned* xst = (volatile LAS unsigned*)(lds + LDS_BYTES - 64);
    if (tid < 2) xst[tid] = 0u;
    __syncthreads();
    const XcdBarrier xbar = xcd_barrier_post((unsigned*)(ws + WS_BAR), xst);
#ifndef PH_MASK
#define PH_MASK 63
#endif
#define IN(k) (((PH_MASK >> (k)) & 1) && lo <= (k) && (k) < hi)
#define SEAM(k) do { if (IN(k) && IN((k) + 1)) { if (lo < 0) grid.sync(); else xcd_barrier(xbar); } } while (0)
#ifndef DUP_MASK
#define DUP_MASK 0
#endif
#define REPS(k) ((((DUP_MASK) >> (k)) & 1) + 1)

    if (IN(0)) for (int rep = 0; rep < REPS(0); ++rep) { if (rep) grid.sync();
        LAS float* scr = (LAS float*)(lds + wave * 16384);
        constexpr int I_IN = (1024 / 64) * (6048 / 32), I_UQ = (256 / 64) * (768 / 32), I_UKV = (128 / 64) * (1024 / 32), I_MEM = (1024 / 64) * (1024 / 32), I_OUT = (2048 / 64) * (1024 / 32);
        constexpr int NITEMS = I_IN + I_UQ + I_UKV + I_MEM + I_OUT;
        for (int it = gw; it < NITEMS; it += NGW) {
            int r = it;
            if (r < I_IN) { tr_item<0>(a.w_in, 1024, 6048, WIN, nullptr, nullptr, nullptr, scr, r, lane); continue; } r -= I_IN;
            if (r < I_UQ) { tr_item<1>(a.w_uq, 256, 768, WUQ, a.g_cq, nullptr, nullptr, scr, r, lane); continue; } r -= I_UQ;
            if (r < I_UKV) { tr_item<2>(a.w_ukv, 128, 1024, WUKV, a.g_ckv, nullptr, nullptr, scr, r, lane); continue; } r -= I_UKV;
            if (r < I_MEM) { tr_item<3>(a.w_mem_kv, 1024, 1024, WMEM, nullptr, nullptr, nullptr, scr, r, lane); continue; } r -= I_MEM;
            tr_item<4>(a.w_out, 2048, 1024, WOUT, a.g_out_a, a.g_out_b, a.g_out_m, scr, r, lane);
        }
        for (int i = bx * NTHREADS + tid; i < 96 * 1024 / 8; i += G * NTHREADS) *(u32x4*)(WIN + (size_t)6048 * 1024 + (size_t)i * 8) = (u32x4){0u, 0u, 0u, 0u};
        {
            f32x4 gg[4], bb[4];
#pragma unroll
            for (int j = 0; j < 4; ++j) { gg[j] = *((const f32x4*)a.g_emb + lane + 64 * j); bb[j] = *((const f32x4*)a.b_emb + lane + 64 * j); }
            f32x4 nx[4];
            if (gw < T) {
#pragma unroll
                for (int j = 0; j < 4; ++j) nx[j] = *((const f32x4*)(a.x + (size_t)gw * DM) + lane + 64 * j);
            }
            for (int m = gw; m < T; m += NGW) {
                f32x4 v[4]; float s = 0.f;
#pragma unroll
                for (int j = 0; j < 4; ++j) { v[j] = nx[j]; s += (v[j][0] + v[j][1]) + (v[j][2] + v[j][3]); }
                if (m + NGW < T) {
#pragma unroll
                    for (int j = 0; j < 4; ++j) nx[j] = *((const f32x4*)(a.x + (size_t)(m + NGW) * DM) + lane + 64 * j);
                }
                const float mean = wave_sum(s) * (1.f / DM); float s2 = 0.f;
#pragma unroll
                for (int j = 0; j < 4; ++j) { v[j] = v[j] - mean; s2 += (v[j][0] * v[j][0] + v[j][1] * v[j][1]) + (v[j][2] * v[j][2] + v[j][3] * v[j][3]); }
                const float rstd = 1.0f / sqrtf(wave_sum(s2) * (1.f / DM) + EPS);
                if (lane == 0) *(f32x2*)(XSTAT + (size_t)m * 2) = (f32x2){mean, rstd};
#pragma unroll
                for (int j = 0; j < 4; ++j) {
                    const f32x4 y = v[j] * rstd * gg[j] + bb[j];
                    u32x2 o2; o2.x = cvtpk(y[0], y[1]); o2.y = cvtpk(y[2], y[3]);
                    *((u32x2*)(H + (size_t)m * DM) + lane + 64 * j) = o2;
                }
            }
        }
        for (int m = gw; m < BATCH * NMEM; m += NGW) {
#pragma unroll
            for (int j = 0; j < 4; ++j) { const f32x4 y = *((const f32x4*)(a.mem + (size_t)m * DM) + lane + 64 * j); u32x2 o2; o2.x = cvtpk(y[0], y[1]); o2.y = cvtpk(y[2], y[3]); *((u32x2*)(MEMB + (size_t)m * DM) + lane + 64 * j) = o2; }
        }
        for (int i = bx * NTHREADS + tid; i < T * 24; i += G * NTHREADS) {
            const int t = i / 24, j = i % 24;
            const double p = (double)a.pos[t];
            const double ang = p * (j < 8 ? INVF_A[j] : INVF_B[j - 8]);
            double rev = ang * 0.15915494309189535; rev = rev - floor(rev);
            const float fr = (float)rev;
            const float cs = __builtin_amdgcn_cosf(fr), sn = __builtin_amdgcn_sinf(fr);
            float* d = (j < 8) ? (ROPEA + (size_t)t * 16 + 2 * j) : (ROPEB + (size_t)t * 32 + 2 * (j - 8));
            *(f32x2*)d = (f32x2){cs, sn};
        }
    }
    SEAM(0);
#ifdef EXTRA_SYNC
    for (int e = 0; e < EXTRA_SYNC; ++e) grid.sync();
#endif

    if (IN(1)) for (int rep = 0; rep < REPS(1); ++rep) { if (rep) grid.sync();
        pg8::Gemm g{H, WIN, DM, DM, DM}; pg8::StaticOrder S; S.init(T, N1, G, bx);
        EpiProj E{PROJ, QHB, KRB, ROPEA, ROPEB, SSQQ, SSQKV};
        pg8::gemm_phase<EpiProj, false>(lds, g, S, E);
    }
    SEAM(1);

    if (IN(2)) for (int rep = 0; rep < REPS(2); ++rep) { if (rep) grid.sync();
#ifndef P2_MASK
#define P2_MASK 7
#endif
        const int G3 = (G * 3) / 4, Gm = G - G3; const bool tail = (bx >= G3);
        if (P2_MASK & 1) { pg8::Gemm g{PROJ + C_CQ, WUQ, NP, 256, 256}; pg8::StaticOrder S; S.init(T, 768, G3, tail ? -1 : bx); EpiQ E{QB, ROPEB, SSQQ}; pg8::gemm_phase<EpiQ, false>(lds, g, S, E); }
        if (P2_MASK & 2) { pg8::Gemm g{PROJ + C_CKV, WUKV, NP, 128, 128}; pg8::StaticOrder S; S.init(T, 1024, tail ? Gm : G3, tail ? bx - G3 : bx);
            const int nkv = (T / 256) * 4; if (tail) S.window(nkv - Gm, nkv); else S.window(0, nkv - Gm);
            EpiKV E{KVB, SSQKV}; pg8::gemm_phase<EpiKV, false>(lds, g, S, E); }
        if (P2_MASK & 4) { pg8::Gemm g{MEMB, WMEM, DM, DM, DM}; pg8::StaticOrder S; S.init(BATCH * NMEM, 1024, Gm, tail ? bx - G3 : -1); EpiPlain E{MKV, 1024}; pg8::gemm_phase<EpiPlain, false>(lds, g, S, E); }
    }
    SEAM(2);

    if (IN(3)) {
        constexpr int U_B = BATCH * 8 * 4, U_A = BATCH * 16 * 4, U_M = BATCH * 4 * 8;
        const bool xcdmap = (G % 8 == 0);
        auto unit_of = [&](int it_) -> int {
            if (xcdmap) { const int L = it_ * (G >> 3) + (bx >> 3), g = (L >> 3) * 8 + (bx & 7); return (g >= (U_B + U_A + U_M) / 8) ? -1 : g * 8 + (L & 7); }
            const int u_ = bx + it_ * G; return (u_ >= U_B + U_A + U_M) ? -1 : u_;
        };
        for (int it = 0;; ++it) {
            const int u = unit_of(it); if (u < 0) break;
#ifndef ATT_MASK
#define ATT_MASK 7
#endif
            if (u < U_B) { if (ATT_MASK & 1) {
                const int b = u / 32, hd = (u >> 2) & 7, qb = u & 3; const size_t r0 = (size_t)b * SEQ, rq = r0 + qb * 512;
                const size_t hb = ((size_t)(b * 8 + hd) * SEQ) * 128;
                attn_dense_unit<96, 64, 64, 2>((LAS char*)lds, QB + rq * 768 + hd * 96, 768, KVB + hb, 128, KRB + r0 * 32, 32,
                                            KVB + hb + 64, 128, SEQ, PROJ + rq * NP + C_BG + hd * 64, NP, SSQY + rq * 32 + 16 + hd);
            } } else if (u < U_B + U_A) { if (ATT_MASK & 2) {
                APf pf;
                auto mk_head = [&](int v_) -> AHead { const int b_ = v_ / 64, hd_ = (v_ >> 2) & 15; const size_t hb = ((size_t)(b_ * 16 + hd_) * SEQ) * 64, tq = (size_t)T * 1024;
                    return AHead{QHB + hb, QHB + tq + hb, QHB + 2 * tq + hb, PROJ + (size_t)b_ * SEQ * NP + C_AG + hd_ * 64}; };
                { const int v = u - U_B; const AHead h0 = mk_head(v); a_first_issue<16>(pf, h0, (v & 3) * 512, wave, lane); }
                for (;;) {
                    const int ucur = unit_of(it);
                    const int v = ucur - U_B, b = v / 64, hd = (v >> 2) & 15, blk = v & 3; const int P0 = blk * 512;
                    const AHead hp = mk_head(v);
                    float* ssqa = SSQY + (size_t)b * SEQ * 32 + hd;
                    const int w1 = wave + 8;
                    attnA_pass<16, 0>((LAS char*)lds, hp, ssqa, P0, wave, lane, pf, [&]() { a_first_issue<16>(pf, hp, P0, w1, lane); });
                    attnA_pass<16, 0>((LAS char*)lds, hp, ssqa, P0, w1, lane, pf, [&]() { a_first_issue<4>(pf, hp, P0, wave, lane); }); __syncthreads();
                    attnA_pass<4, 1>((LAS char*)lds, hp, ssqa, P0, wave, lane, pf, [&]() { a_first_issue<4>(pf, hp, P0, w1, lane); });
                    attnA_pass<4, 1>((LAS char*)lds, hp, ssqa, P0, w1, lane, pf, [&]() { a_first_issue<1>(pf, hp, P0, wave, lane); }); __syncthreads();
                    const int u2 = unit_of(it + 1); const bool nextA = (u2 >= U_B && u2 < U_B + U_A);
                    const int v2 = nextA ? u2 - U_B : v; const AHead hp2 = mk_head(v2); const int P02 = (v2 & 3) * 512;
                    attnA_pass<1, 2>((LAS char*)lds, hp, ssqa, P0, wave, lane, pf, [&]() { a_first_issue<1>(pf, hp, P0, w1, lane); });
                    attnA_pass<1, 2>((LAS char*)lds, hp, ssqa, P0, w1, lane, pf, [&]() { if (nextA) a_first_issue<16>(pf, hp2, P02, wave, lane); });
                    __syncthreads();
                    if (!nextA) break;
                    ++it;
                }
            } } else { if (ATT_MASK & 4) {
                const int v = u - U_B - U_A, b = v / 32, hd = (v >> 3) & 3, qb = v & 7; const size_t rq = (size_t)b * SEQ + qb * 256, rm = (size_t)b * NMEM;
                attn_dense_unit<128, 128, 128, 1>((LAS char*)lds, PROJ + rq * NP + C_MQ + hd * 128, NP, MKV + rm * 1024 + hd * 128, 1024, MKV, 1024,
                                               MKV + rm * 1024 + 512 + hd * 128, 1024, NMEM, PROJ + rq * NP + C_MG + hd * 128, NP, SSQY + rq * 32 + 24 + hd);
            } }
        }
    }
    SEAM(3);

    if (IN(4)) for (int rep = 0; rep < REPS(4); ++rep) { if (rep) grid.sync();
        pg8::Gemm g{PROJ + C_AG, WOUT, NP, 2048, 2048}; pg8::StaticOrder S; S.init(T, DM, G, bx);
        LAS f32x4* rtab = (LAS f32x4*)(lds + pg8::STAGE_BYTES);
        for (int i = 0; i < 2; ++i) { Unit u;
            if (S.next(i, u) && tid < 256) {
                const float* sp = SSQY + ((size_t)u.pm * 256 + tid) * 32;
                float sa = 0.f, sb = 0.f, sm = 0.f;
#pragma unroll
                for (int j = 0; j < 4; ++j) { const f32x4 t4 = *(const f32x4*)(sp + 4 * j); sa += (t4[0] + t4[1]) + (t4[2] + t4[3]); }
#pragma unroll
                for (int j = 4; j < 6; ++j) { const f32x4 t4 = *(const f32x4*)(sp + 4 * j); sb += (t4[0] + t4[1]) + (t4[2] + t4[3]); }
                { const f32x4 t4 = *(const f32x4*)(sp + 24); sm = (t4[0] + t4[1]) + (t4[2] + t4[3]); }
                const float ra = __builtin_amdgcn_rsqf(sa * (1.0f / 1024.0f) + EPS), rb = __builtin_amdgcn_rsqf(sb * (1.0f / 512.0f) + EPS), rm = __builtin_amdgcn_rsqf(sm * (1.0f / 512.0f) + EPS);
                rtab[i * 256 + tid] = (f32x4){ra / rb, rb / rm, rm, 0.f};
            } }
        __syncthreads();
        EpiOut E{QHB, H, PSTAT, rtab};
        pg8::gemm_phase<EpiOut, true>(lds, g, S, E);
    }
    SEAM(4);

    if (IN(5)) {
        f32x4 gg[4], bb[4];
#pragma unroll
        for (int j = 0; j < 4; ++j) { gg[j] = *((const f32x4*)a.g_post + lane + 64 * j); bb[j] = *((const f32x4*)a.b_post + lane + 64 * j); }
        u32x2 npk[4]; f32x2 np = {0.f, 0.f};
        if (gw < T) {
            if (lane < 16) np = *(const f32x2*)(PSTAT + ((size_t)gw * 16 + lane) * 2);
#pragma unroll
            for (int j = 0; j < 4; ++j) npk[j] = *((const u32x2*)(QHB + (size_t)gw * DM) + lane + 64 * j);
        }
        for (int m = gw; m < T; m += NGW) {
            float s = np[0], q = np[1];
            u32x2 pk[4];
#pragma unroll
            for (int j = 0; j < 4; ++j) pk[j] = npk[j];
            if (m + NGW < T) {
                np = (f32x2){0.f, 0.f};
                if (lane < 16) np = *(const f32x2*)(PSTAT + ((size_t)(m + NGW) * 16 + lane) * 2);
#pragma unroll
                for (int j = 0; j < 4; ++j) npk[j] = *((const u32x2*)(QHB + (size_t)(m + NGW) * DM) + lane + 64 * j);
            }
            s = wave_sum(s); q = wave_sum(q);
            const float mean = s * (1.f / DM), var = fmaxf(q * (1.f / DM) - mean * mean, 0.f), rstd = 1.0f / sqrtf(var + EPS);
            f32x4* orow = (f32x4*)(a.out + (size_t)m * DM) + lane;
#pragma unroll
            for (int j = 0; j < 4; ++j) {
                const f32x4 v = {__builtin_bit_cast(float, pk[j].x << 16), __builtin_bit_cast(float, pk[j].x & 0xffff0000u), __builtin_bit_cast(float, pk[j].y << 16), __builtin_bit_cast(float, pk[j].y & 0xffff0000u)};
                orow[64 * j] = (v - mean) * rstd * gg[j] + bb[j];
            }
        }
    }
#undef IN
#undef SEAM
}

extern "C" void kernel_launch(void* const* d_in, const int* in_sizes, int n_in, void* d_out, int out_size, void* d_ws, size_t ws_size, hipStream_t stream) {
    static int grid_blocks = 0;
    if (grid_blocks == 0) {
        int dev = 0, cus = 0, per_cu = 0;
        hipGetDevice(&dev);
        hipDeviceGetAttribute(&cus, hipDeviceAttributeMultiprocessorCount, dev);
        hipFuncSetAttribute((const void*)fwd_mega, hipFuncAttributeMaxDynamicSharedMemorySize, LDS_BYTES);
        hipOccupancyMaxActiveBlocksPerMultiprocessor(&per_cu, (const void*)fwd_mega, NTHREADS, LDS_BYTES);
        if (per_cu < 1) { fprintf(stderr, "kernel_launch: occupancy query reports %d blocks/CU\n", per_cu); per_cu = 1; }
        if (per_cu > 1) per_cu = 1;
        grid_blocks = cus * per_cu;
        if (ws_size < WS_END) { fprintf(stderr, "kernel_launch: workspace too small (%zu < %zu)\n", ws_size, (size_t)WS_END); }
    }
    (void)hipMemsetAsync((unsigned char*)d_ws + WS_BAR, 0, XCD_BAR_WORDS * 4, stream);
    Args a{};
    a.x = (const float*)d_in[0]; a.mem = (const float*)d_in[1]; a.pos = (const int*)d_in[2]; a.g_emb = (const float*)d_in[3]; a.b_emb = (const float*)d_in[4];
    a.w_in = (const float*)d_in[5]; a.g_cq = (const float*)d_in[6]; a.g_ckv = (const float*)d_in[7]; a.w_uq = (const float*)d_in[8]; a.w_ukv = (const float*)d_in[9];
    a.w_mem_kv = (const float*)d_in[10]; a.g_out_a = (const float*)d_in[11]; a.g_out_b = (const float*)d_in[12]; a.g_out_m = (const float*)d_in[13]; a.w_out = (const float*)d_in[14];
    a.g_post = (const float*)d_in[15]; a.b_post = (const float*)d_in[16]; a.out = (float*)d_out; a.ws = (unsigned char*)d_ws; a.ph_lo = 0; a.ph_hi = 6;
    void* args[] = {&a};
    hipError_t e = hipLaunchCooperativeKernel((const void*)fwd_mega, dim3(grid_blocks), dim3(NTHREADS), args, LDS_BYTES, stream);
    if (e != hipSuccess) fprintf(stderr, "cooperative launch failed: %s (grid %d)\n", hipGetErrorString(e), grid_blocks);
}
```

```cpp
#include <hip/hip_runtime.h>
#include <hip/hip_cooperative_groups.h>
#include <cstdio>
#include <cstdint>
namespace cg = cooperative_groups;

#define LAS __attribute__((address_space(3)))
#define DI __device__ __forceinline__
typedef unsigned short bf16_t;
typedef short bf16x8 __attribute__((ext_vector_type(8)));
typedef short s16x4 __attribute__((ext_vector_type(4)));
typedef float f32x4 __attribute__((ext_vector_type(4)));
typedef float f32x2 __attribute__((ext_vector_type(2)));
typedef float f32x16 __attribute__((ext_vector_type(16)));
typedef unsigned u32x4 __attribute__((ext_vector_type(4)));
typedef unsigned u32x2 __attribute__((ext_vector_type(2)));
typedef __bf16 bf16x2_t __attribute__((ext_vector_type(2)));

constexpr int BATCH = 16, SEQ = 2048, DM = 1024, T = BATCH * SEQ, NMEM = 256;
constexpr int N1 = 6144;
constexpr int NP = 3072, WOFF = 3072;
constexpr int C_AG = 0, C_BG = 1024, C_MG = 1536, C_MQ = 2048, C_CQ = 2560, C_CKV = 2816, C_KR = 2944;
constexpr float EPS = 1e-5f;
constexpr float LOG2E = 1.4426950408889634f;
constexpr float ALPHA = 1.189207115002721f;
constexpr float NEGBIG = -1e30f;
constexpr float SM_THR = 8.0f;

constexpr size_t MiB = 1u << 20;
constexpr size_t WS_PROJ = 0, WS_QH = 192 * MiB  , WS_KVB = 384 * MiB, WS_WIN = 448 * MiB, WS_WOUT = 460 * MiB, WS_WMEM = 464 * MiB, WS_WUQ = 466 * MiB, WS_WUKV = 467 * MiB,
                 WS_MEMB = 468 * MiB, WS_MKV = 476 * MiB, WS_ROPEA = 484 * MiB, WS_ROPEB = 486 * MiB, WS_XSTAT = 490 * MiB, WS_SSQQ = 491 * MiB, WS_SSQKV = 492 * MiB,
                 WS_SSQY = 493 * MiB, WS_PSTAT = 497 * MiB, WS_BAR = 501 * MiB, WS_KR = 502 * MiB  , WS_END = 504 * MiB;
constexpr size_t OUT_H = 0, OUT_QB = 64 * MiB;

constexpr int LDS_BYTES = 155648;
constexpr int NTHREADS = 512;

DI unsigned cvtpk(float lo, float hi) { f32x2 v = {lo, hi}; bf16x2_t b = __builtin_convertvector(v, bf16x2_t); return __builtin_bit_cast(unsigned, b); }
DI float bf2f(unsigned short u) { return __builtin_bit_cast(float, (unsigned)u << 16); }
DI float wave_sum(float v) {
#pragma unroll
    for (int o = 1; o < 64; o <<= 1) v += __shfl_xor(v, o);
    return v;
}
DI float fast_exp2(float x) { return __builtin_amdgcn_exp2f(x); }
DI float silu(float g) { return g * __builtin_amdgcn_rcpf(1.0f + fast_exp2(-g * LOG2E)); }

namespace pg8 {
constexpr int BM = 256, BK = 64, HALF = 128, HTB = HALF * BK * 2, STAGE_BYTES = 8 * HTB, NXCD = 8, WGM = 8;
__host__ __device__ __forceinline__ int lds_byte(int r, int c) { const int st = (r >> 4) * 2 + (c >> 5), rr = r & 15, cc = c & 31, ob = rr * 64 + cc * 2; return st * 1024 + (ob ^ (((ob >> 9) & 1) << 5)); }
__host__ __device__ __forceinline__ void stage_rc(int b, int& R, int& C) { const int st = b / 1024, sb = b % 1024, swz = sb ^ (((sb >> 9) & 1) << 5); R = (st >> 1) * 16 + swz / 64; C = (st & 1) * 32 + (swz % 64) / 2; }
__host__ __device__ __forceinline__ int perm32(int rho) { const int n = rho >> 4, i = rho & 15; return 8 * (i >> 2) + 4 * n + (i & 3); }

struct Unit { int pm, pn; };
struct Gemm { const bf16_t* A; const bf16_t* Bt; int lda, ldb, K; };

struct StaticOrder {
    int nM, nN, nwg, G, c, base, limit;
    __device__ void init(int M, int N, int G_, int c_) { nM = M / BM; nN = N / BM; nwg = nM * nN; G = G_; c = c_; base = 0; limit = nwg; }
    __device__ void window(int base_, int limit_) { base = base_; limit = limit_; }
    __device__ bool next(int i, Unit& u) const {
        const long L = (long)base + (long)i * G + c; if (c < 0 || L >= limit) return false;
        int wgid = (int)L; { const int q = nwg / NXCD, r = nwg % NXCD, xcd = wgid % NXCD, off = wgid / NXCD; wgid = (xcd < r ? xcd * (q + 1) : r * (q + 1) + (xcd - r) * q) + off; }
        const int nig = WGM * nN, gid = wgid / nig, fm = gid * WGM, gsz = (nM - fm) < WGM ? (nM - fm) : WGM;
        u.pm = fm + ((wgid % nig) % gsz); u.pn = (wgid % nig) / gsz; return true;
    }
};

template <class Epi, bool HOOK>
DI void gemm_phase(LAS unsigned char* lds, const Gemm g, const StaticOrder& S, const Epi& E) {
    int tid_ = threadIdx.x; asm volatile("" : "+v"(tid_));
    const int tid = tid_, wid = __builtin_amdgcn_readfirstlane(tid >> 6), lane = tid & 63, wr = wid >> 2, wc = wid & 3, fr = lane & 15, fq = lane >> 4;
    const int K = g.K, nt = K / BK;
    unsigned voffA[2], voffB[2];
#pragma unroll
    for (int i = 0; i < 2; ++i) { int R, C; stage_rc(tid * 16 + i * 8192, R, C); const int Rb = (R & ~31) + perm32(R & 31);
        voffA[i] = (unsigned)(R * g.lda + C) * 2u; voffB[i] = (unsigned)(Rb * g.ldb + C) * 2u; }
    const size_t kstep = (size_t)(BK * 2);
    const size_t hstepA = (size_t)HALF * g.lda * 2, hstepB = (size_t)HALF * g.ldb * 2;
    const size_t tstepA = 2 * hstepA, tstepB = 2 * hstepB;
    const unsigned ldsw = (unsigned)wid * 1024u;
    const int aoff = lds_byte(wr * 64 + fr, fq * 8), boff = lds_byte(wc * 32 + fr, fq * 8);
#define PG8_SA(b, h) (((b) * 2 + (h)) * HTB)
#define PG8_SB(b, h) ((4 + (b) * 2 + (h)) * HTB)
#define PG8_STAGE(bufoff, gbase, voff) do { _Pragma("unroll") for (int _i = 0; _i < 2; ++_i) \
        __builtin_amdgcn_global_load_lds((const unsigned*)((const char*)(gbase) + (voff)[_i]), (LAS unsigned*)(lds + (bufoff) + ldsw + _i * 8192), 16, 0, 0); } while (0)
#define PG8_LDA(dst, b, h) do { _Pragma("unroll") for (int m = 0; m < 4; ++m) _Pragma("unroll") for (int k = 0; k < 2; ++k) dst[m][k] = *(const LAS bf16x8*)(lds + PG8_SA(b, h) + aoff + m * 2048 + k * 1024); } while (0)
#define PG8_LDB(dst, b, h) do { _Pragma("unroll") for (int n = 0; n < 2; ++n) _Pragma("unroll") for (int k = 0; k < 2; ++k) dst[n][k] = *(const LAS bf16x8*)(lds + PG8_SB(b, h) + boff + n * 2048 + k * 1024); } while (0)
#define PG8_MMA(ai, bj, At, Bt) do { __builtin_amdgcn_s_setprio(1); _Pragma("unroll") for (int m = 0; m < 4; ++m) _Pragma("unroll") for (int n = 0; n < 2; ++n) _Pragma("unroll") for (int k = 0; k < 2; ++k) \
        acc[ai][bj][m][n] = __builtin_amdgcn_mfma_f32_16x16x32_bf16(Bt[n][k], At[m][k], acc[ai][bj][m][n], 0, 0, 0); __builtin_amdgcn_s_setprio(0); } while (0)
#define PG8_WAIT_V(n) asm volatile("s_waitcnt vmcnt(" #n ")" ::: "memory")
#define PG8_WAIT_L(n) asm volatile("s_waitcnt lgkmcnt(" #n ")" ::: "memory")
#define PG8_BAR __builtin_amdgcn_s_barrier()
#define PG8_SCHED __builtin_amdgcn_sched_barrier(0)
    Unit cur, nxt; int ui = 0;
    if (!S.next(0, cur)) return;
    f32x4 acc[2][2][4][2];
#pragma unroll
    for (int a = 0; a < 2; ++a)
#pragma unroll
        for (int b = 0; b < 2; ++b)
#pragma unroll
            for (int m = 0; m < 4; ++m)
#pragma unroll
                for (int n = 0; n < 2; ++n) acc[a][b][m][n] = (f32x4){0.f, 0.f, 0.f, 0.f};
    bf16x8 At[4][2], B0[2][2], B1[2][2];
    const char* cA = (const char*)g.A + (size_t)cur.pm * tstepA; const char* cB = (const char*)g.Bt + (size_t)cur.pn * tstepB;
    PG8_STAGE(PG8_SB(0, 0), cB, voffB); PG8_STAGE(PG8_SB(0, 1), cB + hstepB, voffB); PG8_STAGE(PG8_SA(0, 0), cA, voffA); PG8_STAGE(PG8_SA(0, 1), cA + hstepA, voffA);
    if (wr == 1) PG8_BAR;
    PG8_WAIT_V(2); PG8_BAR;
    PG8_STAGE(PG8_SB(1, 0), cB + kstep, voffB); PG8_STAGE(PG8_SA(1, 0), cA + kstep, voffA); PG8_STAGE(PG8_SB(1, 1), cB + hstepB + kstep, voffB);
    PG8_WAIT_V(6); PG8_BAR;
    for (;;) {
        const bool has_next = S.next(ui + 1, nxt);
        const char* nA = has_next ? (const char*)g.A + (size_t)nxt.pm * tstepA : cA; const char* nB = has_next ? (const char*)g.Bt + (size_t)nxt.pn * tstepB : cB;
#pragma unroll 1
        for (int t = 0; t < nt; t += 2) {
            const bool last = (t == nt - 2);
            const char* a1 = cA + (size_t)(t + 1) * kstep;
            const char* a2 = last ? nA : cA + (size_t)(t + 2) * kstep; const char* b2 = last ? nB : cB + (size_t)(t + 2) * kstep;
            const char* a3 = a2 + kstep; const char* b3 = b2 + kstep;
            if constexpr (HOOK) { if (t == 16 || t == 24) E.hook(acc, ui, t, wr, fr); }
            PG8_LDB(B0, 0, 0); PG8_LDB(B1, 0, 1); PG8_SCHED; PG8_LDA(At, 0, 0); PG8_STAGE(PG8_SA(1, 1), a1 + hstepA, voffA);
            PG8_WAIT_V(8); PG8_WAIT_L(0); PG8_BAR; PG8_MMA(0, 0, At, B0); PG8_MMA(0, 1, At, B1); PG8_BAR; PG8_SCHED;
            PG8_LDA(At, 0, 1); PG8_STAGE(PG8_SB(0, 0), b2, voffB); PG8_STAGE(PG8_SB(0, 1), b2 + hstepB, voffB); PG8_STAGE(PG8_SA(0, 0), a2, voffA);
            PG8_WAIT_V(8); PG8_WAIT_L(0); PG8_BAR; PG8_MMA(1, 0, At, B0); PG8_MMA(1, 1, At, B1); PG8_BAR; PG8_SCHED;
            PG8_LDB(B0, 1, 0); PG8_LDB(B1, 1, 1); PG8_SCHED; PG8_LDA(At, 1, 0); PG8_STAGE(PG8_SA(0, 1), a2 + hstepA, voffA);
            PG8_WAIT_V(8); PG8_WAIT_L(0); PG8_BAR; PG8_MMA(0, 0, At, B0); PG8_MMA(0, 1, At, B1); PG8_BAR; PG8_SCHED;
            PG8_LDA(At, 1, 1); PG8_STAGE(PG8_SB(1, 0), b3, voffB); PG8_STAGE(PG8_SB(1, 1), b3 + hstepB, voffB); PG8_STAGE(PG8_SA(1, 0), a3, voffA);
            PG8_WAIT_V(8); PG8_WAIT_L(0); PG8_BAR; PG8_MMA(1, 0, At, B0); PG8_MMA(1, 1, At, B1); PG8_BAR; PG8_SCHED;
        }
        if (wr == 0) PG8_BAR;
        E(acc, cur, ui, wr, wc, fr, fq);
        if (!has_next) break;
#pragma unroll
        for (int a = 0; a < 2; ++a)
#pragma unroll
            for (int b = 0; b < 2; ++b)
#pragma unroll
                for (int m = 0; m < 4; ++m)
#pragma unroll
                    for (int n = 0; n < 2; ++n) acc[a][b][m][n] = (f32x4){0.f, 0.f, 0.f, 0.f};
        cur = nxt; cA = nA; cB = nB; ++ui;
        if (wr == 1) PG8_BAR;
    }
    PG8_WAIT_V(0);
    PG8_BAR;
#undef PG8_SA
#undef PG8_SB
#undef PG8_STAGE
#undef PG8_LDA
#undef PG8_LDB
#undef PG8_MMA
#undef PG8_WAIT_V
#undef PG8_WAIT_L
#undef PG8_BAR
#undef PG8_SCHED
}
}
using pg8::Unit;

DI void rope4(f32x4& v0, f32x4& v1, const f32x4 cs0, const f32x4 cs1) {
    f32x4 a = v0, b = v1;
    v0[0] = a[0] * cs0[0] - a[1] * cs0[1]; v0[1] = a[1] * cs0[0] + a[0] * cs0[1];
    v0[2] = a[2] * cs0[2] - a[3] * cs0[3]; v0[3] = a[3] * cs0[2] + a[2] * cs0[3];
    v1[0] = b[0] * cs1[0] - b[1] * cs1[1]; v1[1] = b[1] * cs1[0] + b[0] * cs1[1];
    v1[2] = b[2] * cs1[2] - b[3] * cs1[3]; v1[3] = b[3] * cs1[2] + b[2] * cs1[3];
}
DI void store8(bf16_t* p, const f32x4 v0, const f32x4 v1) {
    u32x4 w; w.x = cvtpk(v0[0], v0[1]); w.y = cvtpk(v0[2], v0[3]); w.z = cvtpk(v1[0], v1[1]); w.w = cvtpk(v1[2], v1[3]);
    *(u32x4*)p = w;
}

struct EpiProj {
    bf16_t* O; bf16_t* QH; bf16_t* KR; const float* ropeA; const float* ropeB; float* ssqq; float* ssqkv;
    DI void hook(f32x4 (&)[2][2][4][2], int, int, int, int) const {}
    DI void operator()(const f32x4 (&acc)[2][2][4][2], const Unit& u, int ui, int wr, int wc, int fr, int fq) const {
        const int row0 = u.pm * 256 + wr * 64 + fr, col0 = u.pn * 256 + wc * 32 + 8 * fq;
        const bool rA = (u.pn < 8) && ((wc & 1) == 0) && (fq < 2);
        const bool rB = (u.pn == 23) && (wc == 0);
        const bool sq = (u.pn >= 22);
#pragma unroll
        for (int ai = 0; ai < 2; ++ai)
#pragma unroll
            for (int m = 0; m < 4; ++m) {
                const int row = row0 + ai * 128 + m * 16;
                f32x4 ca0, ca1, cb0, cb1;
                if (rA) { ca0 = *(const f32x4*)(ropeA + (size_t)row * 16 + 8 * fq); ca1 = *(const f32x4*)(ropeA + (size_t)row * 16 + 8 * fq + 4); }
                if (rB) { cb0 = *(const f32x4*)(ropeB + (size_t)row * 32 + 8 * fq); cb1 = *(const f32x4*)(ropeB + (size_t)row * 32 + 8 * fq + 4); }
                float s0 = 0.f, s1 = 0.f;
#pragma unroll
                for (int bj = 0; bj < 2; ++bj) {
                    f32x4 v0 = acc[ai][bj][m][0], v1 = acc[ai][bj][m][1];
                    const float q = (v0[0] * v0[0] + v0[1] * v0[1]) + (v0[2] * v0[2] + v0[3] * v0[3]) + (v1[0] * v1[0] + v1[1] * v1[1]) + (v1[2] * v1[2] + v1[3] * v1[3]);
                    if (bj == 0) s0 = q; else s1 = q;
                    if (rA) rope4(v0, v1, ca0, ca1);
                    if (rB && bj == 1) rope4(v0, v1, cb0, cb1);
                    if (u.pn < 12) {
                        const int head = (u.pn & 3) * 4 + bj * 2 + (wc >> 1), dim = (wc & 1) * 32 + 8 * fq, bb = row / SEQ, ss = row - bb * SEQ;
                        store8(QH + (size_t)(u.pn >> 2) * ((size_t)T * 1024) + ((size_t)(bb * 16 + head) * SEQ + ss) * 64 + dim, v0, v1);
                    } else if (rB && bj == 1) store8(KR + (size_t)row * 32 + 8 * fq, v0, v1);
                    else store8(O + (size_t)row * NP + (col0 - WOFF) + bj * 128, v0, v1);
                }
                if (sq) {
                    float s = (u.pn == 22) ? (s0 + s1) : s0;
                    s += __shfl_xor(s, 16); s += __shfl_xor(s, 32);
                    if (fq == 0) { float* d = (u.pn == 22) ? ssqq : ssqkv; d[(size_t)row * 4 + wc] = s; }
                }
            }
    }
};
struct EpiQ {
    bf16_t* O; const float* ropeB; const float* ssqq;
    DI void hook(f32x4 (&)[2][2][4][2], int, int, int, int) const {}
    DI void operator()(const f32x4 (&acc)[2][2][4][2], const Unit& u, int ui, int wr, int wc, int fr, int fq) const {
        const int row0 = u.pm * 256 + wr * 64 + fr, col0 = u.pn * 256 + wc * 32 + 8 * fq;
#pragma unroll
        for (int ai = 0; ai < 2; ++ai)
#pragma unroll
            for (int m = 0; m < 4; ++m) {
                const int row = row0 + ai * 128 + m * 16;
                const f32x4 sq = *(const f32x4*)(ssqq + (size_t)row * 4);
                const float rs = __builtin_amdgcn_rsqf(((sq[0] + sq[1]) + (sq[2] + sq[3])) * (1.0f / 256.0f) + EPS);
#pragma unroll
                for (int bj = 0; bj < 2; ++bj) {
                    f32x4 v0 = acc[ai][bj][m][0] * rs, v1 = acc[ai][bj][m][1] * rs;
                    const int cg0 = u.pn * 256 + bj * 128 + wc * 32;
                    if ((cg0 % 96) == 64) { const f32x4 cb0 = *(const f32x4*)(ropeB + (size_t)row * 32 + 8 * fq), cb1 = *(const f32x4*)(ropeB + (size_t)row * 32 + 8 * fq + 4); rope4(v0, v1, cb0, cb1); }
                    store8(O + (size_t)row * 768 + col0 + bj * 128, v0, v1);
                }
                asm volatile("" ::: "memory");
            }
    }
};
struct EpiKV {
    bf16_t* O; const float* ssqkv;
    DI void hook(f32x4 (&)[2][2][4][2], int, int, int, int) const {}
    DI void operator()(const f32x4 (&acc)[2][2][4][2], const Unit& u, int ui, int wr, int wc, int fr, int fq) const {
        const int row0 = u.pm * 256 + wr * 64 + fr, col0 = u.pn * 256 + wc * 32 + 8 * fq;
#pragma unroll
        for (int ai = 0; ai < 2; ++ai)
#pragma unroll
            for (int m = 0; m < 4; ++m) {
                const int row = row0 + ai * 128 + m * 16;
                const f32x4 sq = *(const f32x4*)(ssqkv + (size_t)row * 4);
                const float rs = __builtin_amdgcn_rsqf(((sq[0] + sq[1]) + (sq[2] + sq[3])) * (1.0f / 128.0f) + EPS);
                const int bb = row / SEQ, ss = row - bb * SEQ;
#pragma unroll
                for (int bj = 0; bj < 2; ++bj) store8(O + ((size_t)(bb * 8 + 2 * u.pn + bj) * SEQ + ss) * 128 + wc * 32 + 8 * fq, acc[ai][bj][m][0] * rs, acc[ai][bj][m][1] * rs);
                asm volatile("" ::: "memory");
            }
    }
};
struct EpiPlain {
    bf16_t* O; int ldc;
    DI void hook(f32x4 (&)[2][2][4][2], int, int, int, int) const {}
    DI void operator()(const f32x4 (&acc)[2][2][4][2], const Unit& u, int ui, int wr, int wc, int fr, int fq) const {
        const int row0 = u.pm * 256 + wr * 64 + fr, col0 = u.pn * 256 + wc * 32 + 8 * fq;
#pragma unroll
        for (int ai = 0; ai < 2; ++ai)
#pragma unroll
            for (int m = 0; m < 4; ++m) {
                const int row = row0 + ai * 128 + m * 16;
#pragma unroll
                for (int bj = 0; bj < 2; ++bj) store8(O + (size_t)row * ldc + col0 + bj * 128, acc[ai][bj][m][0], acc[ai][bj][m][1]);
            }
    }
};
struct EpiOut {
    bf16_t* stage; const bf16_t* hb; float* pstat;
    const LAS f32x4* rtab;
    DI void hook(f32x4 (&acc)[2][2][4][2], int ui, int t, int wr, int fr) const {
#pragma unroll
        for (int ai = 0; ai < 2; ++ai)
#pragma unroll
            for (int m = 0; m < 4; ++m) {
                const f32x4 r = rtab[ui * 256 + ai * 128 + wr * 64 + m * 16 + fr];
                const float f = (t == 16) ? r[0] : r[1];
#pragma unroll
                for (int bj = 0; bj < 2; ++bj) { acc[ai][bj][m][0] = acc[ai][bj][m][0] * f; acc[ai][bj][m][1] = acc[ai][bj][m][1] * f; }
            }
    }
    DI void operator()(const f32x4 (&acc)[2][2][4][2], const Unit& u, int ui, int wr, int wc, int fr, int fq) const {
        const int col0 = u.pn * 256 + wc * 32 + 8 * fq;
#pragma unroll
        for (int ai = 0; ai < 2; ++ai)
#pragma unroll
            for (int m = 0; m < 4; ++m) {
                const int rl = ai * 128 + wr * 64 + m * 16 + fr, row = u.pm * 256 + rl;
                const float rsm = rtab[ui * 256 + rl][2];
                float s = 0.f, q = 0.f;
#pragma unroll
                for (int bj = 0; bj < 2; ++bj) {
                    const u32x4 hw = *(const u32x4*)(hb + (size_t)row * DM + col0 + bj * 128);
                    const f32x4 h0 = {__builtin_bit_cast(float, hw.x << 16), __builtin_bit_cast(float, hw.x & 0xffff0000u), __builtin_bit_cast(float, hw.y << 16), __builtin_bit_cast(float, hw.y & 0xffff0000u)};
                    const f32x4 h1 = {__builtin_bit_cast(float, hw.z << 16), __builtin_bit_cast(float, hw.z & 0xffff0000u), __builtin_bit_cast(float, hw.w << 16), __builtin_bit_cast(float, hw.w & 0xffff0000u)};
                    const f32x4 v0 = acc[ai][bj][m][0] * rsm + h0 * ALPHA, v1 = acc[ai][bj][m][1] * rsm + h1 * ALPHA;
                    store8(stage + (size_t)row * DM + col0 + bj * 128, v0, v1);
                    s += ((v0[0] + v0[1]) + (v0[2] + v0[3])) + ((v1[0] + v1[1]) + (v1[2] + v1[3]));
                    q += ((v0[0] * v0[0] + v0[1] * v0[1]) + (v0[2] * v0[2] + v0[3] * v0[3])) + ((v1[0] * v1[0] + v1[1] * v1[1]) + (v1[2] * v1[2] + v1[3] * v1[3]));
                }
                s += __shfl_xor(s, 16); s += __shfl_xor(s, 32); q += __shfl_xor(q, 16); q += __shfl_xor(q, 32);
                if (fq == 0) *(f32x2*)(pstat + ((size_t)row * 16 + u.pn * 4 + wc) * 2) = (f32x2){s, q};
            }
    }
};

DI float xhalf_max(float x) { float a = x, b = x; asm volatile("s_nop 1\n\tv_permlane32_swap_b32 %0, %1" : "+v"(a), "+v"(b)); return fmaxf(a, b); }
#define MFMA32(a, b, c) __builtin_amdgcn_mfma_f32_32x32x16_bf16((a), (b), (c), 0, 0, 0)
DI int crow(int reg, int h) { return (reg & 3) + 8 * (reg >> 2) + 4 * h; }
DI s16x4 vtr(const LAS char* p) { return __builtin_bit_cast(s16x4, __builtin_amdgcn_ds_read_tr16_b64_v4i16((LAS s16x4*)p)); }
DI bf16x8 pack8(const f32x16& x, int s) {
    u32x4 p; p.x = cvtpk(x[8 * s], x[8 * s + 1]); p.y = cvtpk(x[8 * s + 2], x[8 * s + 3]); p.z = cvtpk(x[8 * s + 4], x[8 * s + 5]); p.w = cvtpk(x[8 * s + 6], x[8 * s + 7]);
    return __builtin_bit_cast(bf16x8, p);
}
DI float max16(const f32x16& s) {
    float a = fmaxf(fmaxf(s[0], s[1]), fmaxf(s[2], s[3])), b = fmaxf(fmaxf(s[4], s[5]), fmaxf(s[6], s[7]));
    float c = fmaxf(fmaxf(s[8], s[9]), fmaxf(s[10], s[11])), d = fmaxf(fmaxf(s[12], s[13]), fmaxf(s[14], s[15]));
    return fmaxf(fmaxf(a, b), fmaxf(c, d));
}


template <int DV>
DI void epi_rows(LAS float* buf, const f32x16* o, float inv, bf16_t* gy0  , int gp, float* ssq0, int lane) {
    constexpr int P = DV + 4, CH = DV / 8, RPI = 64 / CH, NIT = 32 / RPI;
    const int r32 = lane & 31, h = lane >> 5;
#pragma unroll
    for (int d = 0; d < DV / 32; ++d)
#pragma unroll
        for (int g = 0; g < 4; ++g) *(LAS f32x4*)(buf + r32 * P + 32 * d + 8 * g + 4 * h) = (f32x4){o[d][4 * g] * inv, o[d][4 * g + 1] * inv, o[d][4 * g + 2] * inv, o[d][4 * g + 3] * inv};
    asm volatile("" ::: "memory");
    const int c = lane % CH, q0 = lane / CH;
#pragma unroll
    for (int i = 0; i < NIT; ++i) {
        const int q = q0 + RPI * i;
        const f32x4 a0 = *(const LAS f32x4*)(buf + q * P + 8 * c), a1 = *(const LAS f32x4*)(buf + q * P + 8 * c + 4);
        bf16_t* gy = gy0 + (size_t)q * gp + 8 * c;
        const u32x4 gw = *(const u32x4*)gy;
        float sq = (a0[0] * a0[0] + a0[1] * a0[1]) + (a0[2] * a0[2] + a0[3] * a0[3]) + (a1[0] * a1[0] + a1[1] * a1[1]) + (a1[2] * a1[2] + a1[3] * a1[3]);
#pragma unroll
        for (int m = 1; m < CH; m <<= 1) sq += __shfl_xor(sq, m);
        u32x4 ow;
        ow.x = cvtpk(a0[0] * silu(__builtin_bit_cast(float, gw.x << 16)), a0[1] * silu(__builtin_bit_cast(float, gw.x & 0xffff0000u)));
        ow.y = cvtpk(a0[2] * silu(__builtin_bit_cast(float, gw.y << 16)), a0[3] * silu(__builtin_bit_cast(float, gw.y & 0xffff0000u)));
        ow.z = cvtpk(a1[0] * silu(__builtin_bit_cast(float, gw.z << 16)), a1[1] * silu(__builtin_bit_cast(float, gw.z & 0xffff0000u)));
        ow.w = cvtpk(a1[2] * silu(__builtin_bit_cast(float, gw.w << 16)), a1[3] * silu(__builtin_bit_cast(float, gw.w & 0xffff0000u)));
        *(u32x4*)gy = ow;
        if (c == 0) ssq0[(size_t)q * 32] = sq;
    }
    asm volatile("" ::: "memory");
}

template <int DQK, int D1, int DV, int QT>
DI void attn_dense_unit(LAS char* lds, const bf16_t* q, int qp, const bf16_t* k1, int k1p, const bf16_t* k2, int k2p, const bf16_t* v, int vp, int nkeys,
                        bf16_t* gate_y, int gp, float* ssq  ) {
    constexpr int KP = DQK * 2 + 16, VP = DV * 2 + (DV == 64 ? 16 : 32);
    constexpr int KT = 64 * KP, VT = 64 * VP, BUF = KT + VT;
    constexpr int KCH = DQK / 8, VCH = DV / 8, NKC = 64 * KCH, NVC = 64 * VCH;
    constexpr int KI = (NKC + NTHREADS - 1) / NTHREADS, VI = (NVC + NTHREADS - 1) / NTHREADS;
    constexpr int NKS = DQK / 16, NDT = DV / 32;
    int tid_ = threadIdx.x; asm volatile("" : "+v"(tid_));
    const int tid = tid_, lane = tid & 63, w = __builtin_amdgcn_readfirstlane(tid >> 6), r32 = lane & 31, h = lane >> 5;
    bf16x8 qf[QT][NKS];
#pragma unroll
    for (int qt = 0; qt < QT; ++qt) { const bf16_t* qr = q + (size_t)((w * QT + qt) * 32 + r32) * qp + 8 * h;
#pragma unroll
      for (int s = 0; s < NKS; ++s) qf[qt][s] = *(const bf16x8*)(qr + 16 * s); }
    u32x4 kreg[KI], vreg[VI];
    auto load_regs = [&](int t) {
#pragma unroll
        for (int i = 0; i < KI; ++i) { const int c = tid + i * NTHREADS; if (NKC % NTHREADS == 0 || c < NKC) { const int r = c / KCH, j = c % KCH; const size_t row = (size_t)(t * 64 + r);
            kreg[i] = (j * 8 < D1) ? *(const u32x4*)(k1 + row * k1p + j * 8) : *(const u32x4*)(k2 + row * k2p + (j * 8 - D1)); } }
#pragma unroll
        for (int i = 0; i < VI; ++i) { const int c = tid + i * NTHREADS; if (NVC % NTHREADS == 0 || c < NVC) { const int r = c / VCH, j = c % VCH; vreg[i] = *(const u32x4*)(v + (size_t)(t * 64 + r) * vp + j * 8); } }
    };
    auto store_lds = [&](int b) {
        LAS char* kb = lds + b * BUF; LAS char* vb = kb + KT;
#pragma unroll
        for (int i = 0; i < KI; ++i) { const int c = tid + i * NTHREADS; if (NKC % NTHREADS == 0 || c < NKC) { const int r = c / KCH, j = c % KCH; *(LAS u32x4*)(kb + r * KP + j * 16) = kreg[i]; } }
#pragma unroll
        for (int i = 0; i < VI; ++i) { const int c = tid + i * NTHREADS; if (NVC % NTHREADS == 0 || c < NVC) { const int r = c / VCH, j = c % VCH; *(LAS u32x4*)(vb + r * VP + j * 16) = vreg[i]; } }
    };
    f32x16 o[QT][NDT]; float mrun[QT], lrun[QT];
#pragma unroll
    for (int qt = 0; qt < QT; ++qt) { mrun[qt] = NEGBIG; lrun[qt] = 0.f;
#pragma unroll
        for (int d = 0; d < NDT; ++d)
#pragma unroll
            for (int i = 0; i < 16; ++i) o[qt][d][i] = 0.f; }
    const int i16 = lane & 15, tq = i16 >> 2, tp = i16 & 3, blk = (lane >> 4) & 1;
    const int voff = (4 * h + tq) * VP + (16 * blk + 4 * tp) * 2;
    const int NT = nkeys / 64;
    load_regs(0); store_lds(0);
#pragma unroll
    for (int qt = 0; qt < QT; ++qt)
#pragma unroll
        for (int s = 0; s < NKS; ++s) asm volatile("" : "+v"(qf[qt][s]));
    __syncthreads();
    for (int t = 0; t < NT; ++t) {
        if (t + 1 < NT) load_regs(t + 1);
        const LAS char* kb = lds + (t & 1) * BUF; const LAS char* vb = kb + KT;
#pragma unroll
        for (int sub = 0; sub < 2; ++sub) {
            f32x16 sc[QT];
#pragma unroll
            for (int qt = 0; qt < QT; ++qt)
#pragma unroll
                for (int i = 0; i < 16; ++i) sc[qt][i] = 0.f;
            __builtin_amdgcn_s_setprio(1);
#pragma unroll
            for (int s = 0; s < NKS; ++s) {
                const bf16x8 a0 = *(const LAS bf16x8*)(kb + (32 * sub + r32) * KP + (16 * s + 8 * h) * 2);
#pragma unroll
                for (int qt = 0; qt < QT; ++qt) sc[qt] = MFMA32(a0, qf[qt][s], sc[qt]);
            }
            __builtin_amdgcn_s_setprio(0);
            bf16x8 pb[QT][2];
#pragma unroll
            for (int qt = 0; qt < QT; ++qt) {
                float mx = max16(sc[qt]); mx = xhalf_max(mx);
                if (__builtin_amdgcn_ballot_w64(mx > mrun[qt] + SM_THR) != 0ull) {
                    const float mupd = fmaxf(mrun[qt], mx), alpha = fast_exp2(mrun[qt] - mupd); lrun[qt] = lrun[qt] * alpha; mrun[qt] = mupd;
#pragma unroll
                    for (int d = 0; d < NDT; ++d) o[qt][d] = o[qt][d] * alpha;
                }
                const float mnew = mrun[qt];
                float rs = 0.f;
#pragma unroll
                for (int i = 0; i < 16; ++i) { sc[qt][i] = fast_exp2(sc[qt][i] - mnew); rs += sc[qt][i]; }
                lrun[qt] = lrun[qt] + rs;
                pb[qt][0] = pack8(sc[qt], 0); pb[qt][1] = pack8(sc[qt], 1);
            }
#pragma unroll
            for (int ks = 0; ks < 2; ++ks) {
                const LAS char* vr = vb + voff + (32 * sub + 16 * ks) * VP;
#pragma unroll
                for (int d = 0; d < NDT; ++d) {
                    const s16x4 lo = vtr(vr + d * 64), hi = vtr(vr + 8 * VP + d * 64);
                    const bf16x8 va = __builtin_shufflevector(lo, hi, 0, 1, 2, 3, 4, 5, 6, 7);
#pragma unroll
                    for (int qt = 0; qt < QT; ++qt) o[qt][d] = MFMA32(va, pb[qt][ks], o[qt][d]);
                }
            }
        }
        if (t + 1 < NT) store_lds((t + 1) & 1);
        __syncthreads();
    }
#pragma unroll
    for (int qt = 0; qt < QT; ++qt) {
        const float ltot = lrun[qt] + __shfl_xor(lrun[qt], 32), inv = 1.0f / ltot;
        const int row0 = (w * QT + qt) * 32;
        epi_rows<DV>((LAS float*)(lds + w * (32 * (DV + 4) * 4)), o[qt], inv, gate_y + (size_t)row0 * gp, gp, ssq + (size_t)row0 * 32, lane);
    }
    __syncthreads();
}

constexpr int A_OSTP = 64;
DI int a_swz(int row, int chunk) { return ((chunk ^ row ^ (row >> 4)) & 15) * 4; }
constexpr int A_VP = 144, A_VWB = 2 * 32 * A_VP, A_VW_OFF = 0, A_ST_OFF = 8 * A_VWB, A_ML_OFF = A_ST_OFF + 512 * 128;
DI int st_swz(int row, int chunk) { return ((chunk ^ row ^ (row >> 4)) & 15) * 8; }
struct AHead { const bf16_t* q; const bf16_t* k; const bf16_t* v; bf16_t* gate; };
struct APf { u32x4 kc[4], vc[4]; bf16x8 qf[4]; };
template <int DIL> DI void a_geom(int P0, int w, int r32, int& qpos, int& kb0) {
    if (DIL == 16) { qpos = P0 + w + 16 * r32; kb0 = w; }
    else if (DIL == 4) { const int base = P0 + 128 * (w >> 2) + (w & 3); qpos = base + 4 * r32; kb0 = base - 256; }
    else { const int base = P0 + 32 * w; qpos = base + r32; kb0 = base - 64; }
}
template <int DIL> DI int a_kbase(int w, int kb0, int i) { return kb0 + DIL * 32 * i; }
DI int a_clamp(int p) { return p < 0 ? 0 : (p > SEQ - 1 ? SEQ - 1 : p); }
template <int DIL> DI void a_issue_kv(APf& pf, const AHead& hp, int kb, int lane) {
    const int kbs = __builtin_amdgcn_readfirstlane(((unsigned)kb < (unsigned)SEQ) ? kb : 0);
    const char* sbk = (const char*)(hp.k + (size_t)kbs * 64); const char* sbv = (const char*)(hp.v + (size_t)kbs * 64);
#pragma unroll
    for (int j = 0; j < 4; ++j) { const int c = lane + 64 * j, r = c >> 3, ch = c & 7; const unsigned vo = (unsigned)(DIL * r * 64 + 8 * ch) * 2u;
        pf.kc[j] = *(const u32x4*)(sbk + vo); pf.vc[j] = *(const u32x4*)(sbv + vo); }
}
template <int DIL> DI void a_first_issue(APf& pf, const AHead& hp, int P0, int w, int lane) {
    const int r32 = lane & 31, h = lane >> 5; int qpos, kb0; a_geom<DIL>(P0, w, r32, qpos, kb0);
    const bf16_t* qr = hp.q + (size_t)qpos * 64 + 8 * h;
#pragma unroll
    for (int s = 0; s < 4; ++s) pf.qf[s] = *(const bf16x8*)(qr + 16 * s);
    a_issue_kv<DIL>(pf, hp, a_kbase<DIL>(w, kb0, 0), lane);
}
template <int DIL, int PASS, class NextFn>
DI void attnA_pass(LAS char* lds, const AHead& hp, float* ssq  , int P0, int w, int lane_, APf& pf, NextFn next_issue) {
    int lane = lane_; asm volatile("" : "+v"(lane));
    const int r32 = lane & 31, h = lane >> 5;
    int qpos, kb0; constexpr int NSUB = (DIL == 16) ? 4 : 5;
    a_geom<DIL>(P0, w, r32, qpos, kb0);
    const int qloc = qpos - P0;
    LAS char* stt = lds + A_ST_OFF; LAS float* ml = (LAS float*)(lds + A_ML_OFF); LAS char* vw = lds + A_VW_OFF + (w & 7) * A_VWB;
    f32x16 o[2]; float mrun, lrun;
    if (PASS == 0) {
#pragma unroll
        for (int d = 0; d < 2; ++d)
#pragma unroll
            for (int i = 0; i < 16; ++i) o[d][i] = 0.f;
        mrun = NEGBIG; lrun = 0.f;
    } else {
#pragma unroll
        for (int d = 0; d < 2; ++d)
#pragma unroll
            for (int g = 0; g < 4; ++g) { const u32x2 t2 = *(const LAS u32x2*)(stt + qloc * 128 + st_swz(qloc, 8 * d + 2 * g + h));
                o[d][4 * g] = __builtin_bit_cast(float, t2.x << 16); o[d][4 * g + 1] = __builtin_bit_cast(float, t2.x & 0xffff0000u); o[d][4 * g + 2] = __builtin_bit_cast(float, t2.y << 16); o[d][4 * g + 3] = __builtin_bit_cast(float, t2.y & 0xffff0000u); }
        const f32x2 mlv = *(const LAS f32x2*)(ml + qloc * 2); mrun = mlv[0]; lrun = (h == 0) ? mlv[1] : 0.f;
    }
    auto kbase_of = [&](int i) -> int { return a_kbase<DIL>(w, kb0, i); };
    LAS char* kw = vw; LAS char* vw2 = vw + 32 * A_VP;
    auto issue = [&](int i) { a_issue_kv<DIL>(pf, hp, kbase_of(i), lane); };
    auto vstore = [&]() {
#pragma unroll
        for (int j = 0; j < 4; ++j) { const int c = lane + 64 * j, r = c >> 3, ch = c & 7; *(LAS u32x4*)(kw + r * A_VP + ch * 16) = pf.kc[j]; *(LAS u32x4*)(vw2 + r * A_VP + ch * 16) = pf.vc[j]; }
        asm volatile("" ::: "memory");
    };
    const int i16 = lane & 15, tq = i16 >> 2, tp = i16 & 3, blk = (lane >> 4) & 1;
    const int voff = (4 * h + tq) * A_VP + (16 * blk + 4 * tp) * 2;
    const int koff = r32 * A_VP + 16 * h;
    APf pb2;
    a_issue_kv<DIL>(pb2, hp, kbase_of(1), lane);
    auto vstoreB = [&]() {
#pragma unroll
        for (int j = 0; j < 4; ++j) { const int c = lane + 64 * j, r = c >> 3, ch = c & 7; *(LAS u32x4*)(kw + r * A_VP + ch * 16) = pb2.kc[j]; *(LAS u32x4*)(vw2 + r * A_VP + ch * 16) = pb2.vc[j]; }
        asm volatile("" ::: "memory");
    };
    bf16x8 qf[4];
#pragma unroll
    for (int s = 0; s < 4; ++s) qf[s] = pf.qf[s];
    auto compute = [&](int i) {
        const int kb = kbase_of(i);
        bool live;
        if (DIL == 16) { const int t0 = 32 * i, q0 = P0 >> 4; live = (t0 + 31 >= q0 - 64) && (t0 <= q0 + 95); }
        else live = (unsigned)kb < (unsigned)SEQ;
        if (live) {
        f32x16 st;
#pragma unroll
        for (int j = 0; j < 16; ++j) st[j] = 0.f;
#pragma unroll
        for (int s = 0; s < 4; ++s) { const bf16x8 ka = *(const LAS bf16x8*)(kw + koff + 32 * s); st = MFMA32(ka, qf[s], st); }
        if (DIL == 16) {
            const int jq = (P0 >> 4) + r32;
            const int tt = 32 * i + 4 * h - jq + 64;
#pragma unroll
            for (int j = 0; j < 16; ++j) st[j] = ((unsigned)(tt + ((j & 3) + 8 * (j >> 2))) <= 128u) ? st[j] : NEGBIG;
        } else if (i == 0) {
#pragma unroll
            for (int j = 0; j < 16; ++j) st[j] = (crow(j, h) >= r32) ? st[j] : NEGBIG;
        } else if (i == 4) {
#pragma unroll
            for (int j = 0; j < 16; ++j) st[j] = (crow(j, h) <= r32) ? st[j] : NEGBIG;
        }
        float mx = max16(st); mx = xhalf_max(mx);
        if (__builtin_amdgcn_ballot_w64(mx > mrun + SM_THR) != 0ull) { const float mupd = fmaxf(mrun, mx), alpha = fast_exp2(mrun - mupd); lrun = lrun * alpha; o[0] = o[0] * alpha; o[1] = o[1] * alpha; mrun = mupd; }
        const float mnew = mrun;
        float rs = 0.f;
#pragma unroll
        for (int j = 0; j < 16; ++j) { st[j] = fast_exp2(st[j] - mnew); rs += st[j]; }
        lrun = lrun + rs;
#pragma unroll
        for (int ks = 0; ks < 2; ++ks) {
            const bf16x8 pb = pack8(st, ks);
            const LAS char* vr = vw2 + voff + (16 * ks) * A_VP;
#pragma unroll
            for (int d = 0; d < 2; ++d) {
                const s16x4 lo = vtr(vr + d * 64), hi = vtr(vr + 8 * A_VP + d * 64);
                const bf16x8 va = __builtin_shufflevector(lo, hi, 0, 1, 2, 3, 4, 5, 6, 7);
                o[d] = MFMA32(va, pb, o[d]);
            }
        }
        }
        asm volatile("" ::: "memory");
    };
    vstore();
#pragma unroll
    for (int s = 0; s < 4; ++s) asm volatile("" : "+v"(qf[s]));
    if (2 < NSUB) issue(2);
    compute(0);
#pragma unroll 1
    for (int i = 1; i < NSUB; i += 2) {
        vstoreB(); if (i + 2 < NSUB) a_issue_kv<DIL>(pb2, hp, kbase_of(i + 2), lane); compute(i);
        if (i + 1 < NSUB) { vstore(); if (i + 3 < NSUB) issue(i + 3); compute(i + 1); }
    }
    next_issue();
    if (PASS < 2) {
#pragma unroll
        for (int d = 0; d < 2; ++d)
#pragma unroll
            for (int g = 0; g < 4; ++g) { u32x2 ow; ow.x = cvtpk(o[d][4 * g], o[d][4 * g + 1]); ow.y = cvtpk(o[d][4 * g + 2], o[d][4 * g + 3]); *(LAS u32x2*)(stt + qloc * 128 + st_swz(qloc, 8 * d + 2 * g + h)) = ow; }
        const float ltot = lrun + __shfl_xor(lrun, 32);
        if (h == 0) *(LAS f32x2*)(ml + qloc * 2) = (f32x2){mrun, ltot};
    } else {
        const float ltot = lrun + __shfl_xor(lrun, 32), inv = 1.0f / ltot;
        const int q0pos = qpos - r32;
        epi_rows<64>((LAS float*)vw, o, inv, hp.gate + (size_t)q0pos * NP, NP, ssq + (size_t)q0pos * 32, lane);
    }
}

DI int win_dst(int n, float& scale) {
    scale = 1.0f;
    if (n < 2048) { const int d = n & 63, base = n - d; if (n < 1024) scale = 0.125f * LOG2E; return base + (d < 16 ? ((d & 7) * 2 + (d >> 3)) : d); }
    if (n < 4096) return n;
    if (n < 4352) return WOFF + C_CQ + (n - 4096);
    if (n < 4480) return WOFF + C_CKV + (n - 4352);
    if (n < 4512) { const int d = n - 4480; return WOFF + C_KR + ((d & 15) * 2 + (d >> 4)); }
    if (n < 5024) return WOFF + C_BG + (n - 4512);
    if (n < 5536) { scale = 0.08838834764831845f * LOG2E; return WOFF + C_MQ + (n - 5024); }
    return WOFF + C_MG + (n - 5536);
}
template <int MODE>
DI void tr_item(const float* W, int K, int N, bf16_t* WT, const float* g0, const float* g1, const float* g2, LAS float* scr, int item, int lane) {
    const int nblk = N / 32, kb = item / nblk, nb = item % nblk, k0 = 64 * kb, n0 = 32 * nb;
    float wv[32];
#pragma unroll
    for (int i = 0; i < 32; ++i) { const int kk = 2 * i + (lane >> 5); wv[i] = W[(size_t)(k0 + kk) * N + n0 + (lane & 31)]; }
#pragma unroll
    for (int i = 0; i < 32; ++i) { const int kk = 2 * i + (lane >> 5); scr[kk * 33 + (lane & 31)] = wv[i]; }
    asm volatile("s_waitcnt lgkmcnt(0)" ::: "memory");
    const int c = lane & 7;
    float gk[8];
#pragma unroll
    for (int e = 0; e < 8; ++e) { const int k = k0 + 8 * c + e;
        if (MODE == 1 || MODE == 2) gk[e] = g0[k];
        else if (MODE == 4) gk[e] = (k < 1024) ? g0[k] : (k < 1536 ? g1[k - 1024] : g2[k - 1536]);
        else gk[e] = 1.0f; }
#pragma unroll
    for (int j = 0; j < 4; ++j) {
        const int nl = (lane >> 3) + 8 * j, n = n0 + nl; float sc = 1.0f; int dst = n;
        if (MODE == 0) dst = win_dst(n, sc);
        if (MODE == 1) { const int hd = n / 96, d = n % 96; sc = 0.10206207261596575f * LOG2E; if (d >= 64) { const int r = d - 64; dst = hd * 96 + 64 + ((r & 15) * 2 + (r >> 4)); } }
        const LAS float* s = scr + (8 * c) * 33 + nl;
        u32x4 o4; o4.x = cvtpk(s[0 * 33] * gk[0] * sc, s[1 * 33] * gk[1] * sc); o4.y = cvtpk(s[2 * 33] * gk[2] * sc, s[3 * 33] * gk[3] * sc);
        o4.z = cvtpk(s[4 * 33] * gk[4] * sc, s[5 * 33] * gk[5] * sc); o4.w = cvtpk(s[6 * 33] * gk[6] * sc, s[7 * 33] * gk[7] * sc);
        *(u32x4*)(WT + (size_t)dst * K + k0 + 8 * c) = o4;
    }
    asm volatile("s_waitcnt lgkmcnt(0)" ::: "memory");
}

__constant__ double INVF_A[8] = {1.0, 0.19390103887252767, 0.037597612875247145, 0.007290216193692821, 0.0014135804504232794, 0.00027409471785274054, 5.3147250536566735e-05, 1.0305307092165658e-05};
__constant__ double INVF_B[16] = {1.0, 0.44034195675670255, 0.19390103887252767, 0.08538276288621138, 0.037597612875247145, 0.016555806424970463, 0.007290216193692821, 0.0032101880639213203,
                                  0.0014135804504232794, 0.0006224587813827168, 0.00027409471785274054, 0.00012069540440475095, 5.3147250536566735e-05, 2.3402964294289857e-05, 1.0305307092165658e-05, 4.537859090181327e-06};


#define XB_TMO      128
#define XB_XCNT(j)  (256  + 64 * (j))
#define XB_XSUB(j)  (1280 + 64 * (j))
#define XB_XGEN(j)  (2304 + 64 * (j))
#define XB_TOP      3328
#define XB_TOPGEN   3392
#define XCD_BAR_WORDS 3456
#define XB_SPIN_CAP (1u << 18)
DI unsigned xb_ld(unsigned* p)              { return __hip_atomic_load(p, __ATOMIC_RELAXED, __HIP_MEMORY_SCOPE_AGENT); }
DI unsigned xb_add(unsigned* p, unsigned v) { return __hip_atomic_fetch_add(p, v, __ATOMIC_RELAXED, __HIP_MEMORY_SCOPE_AGENT); }
DI unsigned xb_xcc_id() { return (unsigned)__builtin_amdgcn_s_getreg((3 << 11) | 20) & 0xFu; }
#define XB_SPIN(cond, bar) do { unsigned _sp = 0; while (cond) { __builtin_amdgcn_s_sleep(1); \
    if ((++_sp & 255u) == 0u) { if (xb_ld(&(bar)[XB_TMO])) break; if (_sp > XB_SPIN_CAP) { atomicAdd(&(bar)[XB_TMO], 1u); break; } } } } while (0)
struct XcdBarrier { unsigned* bar; unsigned x; volatile LAS unsigned* st; };
DI XcdBarrier xcd_barrier_post(unsigned* bar, volatile LAS unsigned* st) {
    XcdBarrier b; b.bar = bar; b.x = xb_xcc_id(); b.st = st;
    if (threadIdx.x == 0) (void)xb_add(&bar[XB_XCNT(b.x)], 1u);
    return b;
}
DI void xcd_barrier_complete(unsigned* bar, unsigned x, unsigned& nloc, unsigned& nx) {
    const unsigned G = gridDim.x * gridDim.y * gridDim.z;
    unsigned sum, cnt, mine, sp = 0u;
    for (;;) {
        sum = 0u; cnt = 0u; mine = 0u;
#pragma unroll
        for (unsigned j = 0; j < 16; ++j) { const unsigned c = xb_ld(&bar[XB_XCNT(j)]); sum += c; cnt += (c > 0u) ? 1u : 0u; mine = (j == x) ? c : mine; }
        if (sum == G) break;
        __builtin_amdgcn_s_sleep(1);
        if ((++sp & 255u) == 0u) { if (xb_ld(&bar[XB_TMO])) break; if (sp > XB_SPIN_CAP) { atomicAdd(&bar[XB_TMO], 1u); break; } }
    }
    nloc = mine > 0u ? mine : 1u; nx = cnt > 0u ? cnt : 1u;
}
DI void xcd_barrier(const XcdBarrier& b) {
    asm volatile("s_waitcnt vmcnt(0)" ::: "memory");
    __syncthreads();
    if (threadIdx.x == 0) {
        unsigned* bar = b.bar;
        __builtin_amdgcn_s_waitcnt(0);
        unsigned nloc = b.st[0], nx = b.st[1];
        if (nloc == 0u) { xcd_barrier_complete(bar, b.x, nloc, nx); b.st[0] = nloc; b.st[1] = nx; }
        const unsigned old = xb_add(&bar[XB_XSUB(b.x)], 1u);
        const unsigned gen = old / nloc;
        if (old + 1u == (gen + 1u) * nloc) {
            __builtin_amdgcn_fence(__ATOMIC_RELEASE, "agent");
            asm volatile("s_waitcnt vmcnt(0)" ::: "memory");
            const unsigned og = xb_add(&bar[XB_TOP], 1u);
            const unsigned tg = og / nx;
            if (og + 1u == (tg + 1u) * nx) xb_add(&bar[XB_TOPGEN], 1u);
            else XB_SPIN(xb_ld(&bar[XB_TOPGEN]) == tg, bar);
            __builtin_amdgcn_fence(__ATOMIC_ACQUIRE, "agent");
            xb_add(&bar[XB_XGEN(b.x)], 1u);
            asm volatile("s_waitcnt vmcnt(0)" ::: "memory");
        } else {
            XB_SPIN(xb_ld(&bar[XB_XGEN(b.x)]) == gen, bar);
            __builtin_amdgcn_fence(__ATOMIC_ACQUIRE, "agent");
            asm volatile("s_waitcnt vmcnt(0)" ::: "memory");
        }
    }
    __syncthreads();
}

struct Args {
    const float* x; const float* mem; const int* pos; const float* g_emb; const float* b_emb; const float* w_in; const float* g_cq; const float* g_ckv;
    const float* w_uq; const float* w_ukv; const float* w_mem_kv; const float* g_out_a; const float* g_out_b; const float* g_out_m; const float* w_out;
    const float* g_post; const float* b_post; float* out; unsigned char* ws; int ph_lo, ph_hi;
};

__global__ void __launch_bounds__(NTHREADS, 2) fwd_mega(Args a) {
    extern __shared__ __attribute__((aligned(16))) unsigned char lds_raw[];
    LAS unsigned char* lds = (LAS unsigned char*)lds_raw;
    cg::grid_group grid = cg::this_grid();
    const int tid = threadIdx.x, lane = tid & 63, wave = __builtin_amdgcn_readfirstlane(tid >> 6);
    const int G = gridDim.x, bx = blockIdx.x;
    const int gw = bx * 8 + wave, NGW = G * 8;
    unsigned char* ws = a.ws;
    bf16_t* PROJ = (bf16_t*)(ws + WS_PROJ); bf16_t* QHB = (bf16_t*)(ws + WS_QH); bf16_t* KRB = (bf16_t*)(ws + WS_KR); bf16_t* KVB = (bf16_t*)(ws + WS_KVB); bf16_t* WIN = (bf16_t*)(ws + WS_WIN); bf16_t* WOUT = (bf16_t*)(ws + WS_WOUT);
    bf16_t* WMEM = (bf16_t*)(ws + WS_WMEM); bf16_t* WUQ = (bf16_t*)(ws + WS_WUQ); bf16_t* WUKV = (bf16_t*)(ws + WS_WUKV); bf16_t* MEMB = (bf16_t*)(ws + WS_MEMB);
    bf16_t* MKV = (bf16_t*)(ws + WS_MKV); float* ROPEA = (float*)(ws + WS_ROPEA); float* ROPEB = (float*)(ws + WS_ROPEB); float* XSTAT = (float*)(ws + WS_XSTAT);
    float* SSQQ = (float*)(ws + WS_SSQQ); float* SSQKV = (float*)(ws + WS_SSQKV); float* SSQY = (float*)(ws + WS_SSQY); float* PSTAT = (float*)(ws + WS_PSTAT);
    bf16_t* H = (bf16_t*)((unsigned char*)a.out + OUT_H); bf16_t* QB = (bf16_t*)((unsigned char*)a.out + OUT_QB);
    const int lo = a.ph_lo, hi = a.ph_hi;
    volatile LAS unsigned* xst = (volatile LAS unsigned*)(lds + LDS_BYTES - 64);
    if (tid < 2) xst[tid] = 0u;
    __syncthreads();
    const XcdBarrier xbar = xcd_barrier_post((unsigned*)(ws + WS_BAR), xst);
#ifndef PH_MASK
#define PH_MASK 63
#endif
#define IN(k) (((PH_MASK >> (k)) & 1) && lo <= (k) && (k) < hi)
#define SEAM(k) do { if (IN(k) && IN((k) + 1)) { if (lo < 0) grid.sync(); else xcd_barrier(xbar); } } while (0)
#ifndef DUP_MASK
#define DUP_MASK 0
#endif
#define REPS(k) ((((DUP_MASK) >> (k)) & 1) + 1)

    if (IN(0)) for (int rep = 0; rep < REPS(0); ++rep) { if (rep) grid.sync();
        LAS float* scr = (LAS float*)(lds + wave * 16384);
        constexpr int I_IN = (1024 / 64) * (6048 / 32), I_UQ = (256 / 64) * (768 / 32), I_UKV = (128 / 64) * (1024 / 32), I_MEM = (1024 / 64) * (1024 / 32), I_OUT = (2048 / 64) * (1024 / 32);
        constexpr int NITEMS = I_IN + I_UQ + I_UKV + I_MEM + I_OUT;
        for (int it = gw; it < NITEMS; it += NGW) {
            int r = it;
            if (r < I_IN) { tr_item<0>(a.w_in, 1024, 6048, WIN, nullptr, nullptr, nullptr, scr, r, lane); continue; } r -= I_IN;
            if (r < I_UQ) { tr_item<1>(a.w_uq, 256, 768, WUQ, a.g_cq, nullptr, nullptr, scr, r, lane); continue; } r -= I_UQ;
            if (r < I_UKV) { tr_item<2>(a.w_ukv, 128, 1024, WUKV, a.g_ckv, nullptr, nullptr, scr, r, lane); continue; } r -= I_UKV;
            if (r < I_MEM) { tr_item<3>(a.w_mem_kv, 1024, 1024, WMEM, nullptr, nullptr, nullptr, scr, r, lane); continue; } r -= I_MEM;
            tr_item<4>(a.w_out, 2048, 1024, WOUT, a.g_out_a, a.g_out_b, a.g_out_m, scr, r, lane);
        }
        for (int i = bx * NTHREADS + tid; i < 96 * 1024 / 8; i += G * NTHREADS) *(u32x4*)(WIN + (size_t)6048 * 1024 + (size_t)i * 8) = (u32x4){0u, 0u, 0u, 0u};
        {
            f32x4 gg[4], bb[4];
#pragma unroll
            for (int j = 0; j < 4; ++j) { gg[j] = *((const f32x4*)a.g_emb + lane + 64 * j); bb[j] = *((const f32x4*)a.b_emb + lane + 64 * j); }
            f32x4 nx[4];
            if (gw < T) {
#pragma unroll
                for (int j = 0; j < 4; ++j) nx[j] = *((const f32x4*)(a.x + (size_t)gw * DM) + lane + 64 * j);
            }
            for (int m = gw; m < T; m += NGW) {
                f32x4 v[4]; float s = 0.f;
#pragma unroll
                for (int j = 0; j < 4; ++j) { v[j] = nx[j]; s += (v[j][0] + v[j][1]) + (v[j][2] + v[j][3]); }
                if (m + NGW < T) {
#pragma unroll
                    for (int j = 0; j < 4; ++j) nx[j] = *((const f32x4*)(a.x + (size_t)(m + NGW) * DM) + lane + 64 * j);
                }
                const float mean = wave_sum(s) * (1.f / DM); float s2 = 0.f;
#pragma unroll
                for (int j = 0; j < 4; ++j) { v[j] = v[j] - mean; s2 += (v[j][0] * v[j][0] + v[j][1] * v[j][1]) + (v[j][2] * v[j][2] + v[j][3] * v[j][3]); }
                const float rstd = 1.0f / sqrtf(wave_sum(s2) * (1.f / DM) + EPS);
                if (lane == 0) *(f32x2*)(XSTAT + (size_t)m * 2) = (f32x2){mean, rstd};
#pragma unroll
                for (int j = 0; j < 4; ++j) {
                    const f32x4 y = v[j] * rstd * gg[j] + bb[j];
                    u32x2 o2; o2.x = cvtpk(y[0], y[1]); o2.y = cvtpk(y[2], y[3]);
                    *((u32x2*)(H + (size_t)m * DM) + lane + 64 * j) = o2;
                }
            }
        }
        for (int m = gw; m < BATCH * NMEM; m += NGW) {
#pragma unroll
            for (int j = 0; j < 4; ++j) { const f32x4 y = *((const f32x4*)(a.mem + (size_t)m * DM) + lane + 64 * j); u32x2 o2; o2.x = cvtpk(y[0], y[1]); o2.y = cvtpk(y[2], y[3]); *((u32x2*)(MEMB + (size_t)m * DM) + lane + 64 * j) = o2; }
        }
        for (int i = bx * NTHREADS + tid; i < T * 24; i += G * NTHREADS) {
            const int t = i / 24, j = i % 24;
            const double p = (double)a.pos[t];
            const double ang = p * (j < 8 ? INVF_A[j] : INVF_B[j - 8]);
            double rev = ang * 0.15915494309189535; rev = rev - floor(rev);
            const float fr = (float)rev;
            const float cs = __builtin_amdgcn_cosf(fr), sn = __builtin_amdgcn_sinf(fr);
            float* d = (j < 8) ? (ROPEA + (size_t)t * 16 + 2 * j) : (ROPEB + (size_t)t * 32 + 2 * (j - 8));
            *(f32x2*)d = (f32x2){cs, sn};
        }
    }
    SEAM(0);
#ifdef EXTRA_SYNC
    for (int e = 0; e < EXTRA_SYNC; ++e) grid.sync();
#endif

    if (IN(1)) for (int rep = 0; rep < REPS(1); ++rep) { if (rep) grid.sync();
        pg8::Gemm g{H, WIN, DM, DM, DM}; pg8::StaticOrder S; S.init(T, N1, G, bx);
        EpiProj E{PROJ, QHB, KRB, ROPEA, ROPEB, SSQQ, SSQKV};
        pg8::gemm_phase<EpiProj, false>(lds, g, S, E);
    }
    SEAM(1);

    if (IN(2)) for (int rep = 0; rep < REPS(2); ++rep) { if (rep) grid.sync();
#ifndef P2_MASK
#define P2_MASK 7
#endif
        const int G3 = (G * 3) / 4, Gm = G - G3; const bool tail = (bx >= G3);
        if (P2_MASK & 1) { pg8::Gemm g{PROJ + C_CQ, WUQ, NP, 256, 256}; pg8::StaticOrder S; S.init(T, 768, G3, tail ? -1 : bx); EpiQ E{QB, ROPEB, SSQQ}; pg8::gemm_phase<EpiQ, false>(lds, g, S, E); }
        if (P2_MASK & 2) { pg8::Gemm g{PROJ + C_CKV, WUKV, NP, 128, 128}; pg8::StaticOrder S; S.init(T, 1024, tail ? Gm : G3, tail ? bx - G3 : bx);
            const int nkv = (T / 256) * 4; if (tail) S.window(nkv - Gm, nkv); else S.window(0, nkv - Gm);
            EpiKV E{KVB, SSQKV}; pg8::gemm_phase<EpiKV, false>(lds, g, S, E); }
        if (P2_MASK & 4) { pg8::Gemm g{MEMB, WMEM, DM, DM, DM}; pg8::StaticOrder S; S.init(BATCH * NMEM, 1024, Gm, tail ? bx - G3 : -1); EpiPlain E{MKV, 1024}; pg8::gemm_phase<EpiPlain, false>(lds, g, S, E); }
    }
    SEAM(2);

    if (IN(3)) {
        constexpr int U_B = BATCH * 8 * 4, U_A = BATCH * 16 * 4, U_M = BATCH * 4 * 8;
        const bool xcdmap = (G % 8 == 0);
        auto unit_of = [&](int it_) -> int {
            if (xcdmap) { const int L = it_ * (G >> 3) + (bx >> 3), g = (L >> 3) * 8 + (bx & 7); return (g >= (U_B + U_A + U_M) / 8) ? -1 : g * 8 + (L & 7); }
            const int u_ = bx + it_ * G; return (u_ >= U_B + U_A + U_M) ? -1 : u_;
        };
        for (int it = 0;; ++it) {
            const int u = unit_of(it); if (u < 0) break;
#ifndef ATT_MASK
#define ATT_MASK 7
#endif
            if (u < U_B) { if (ATT_MASK & 1) {
                const int b = u / 32, hd = (u >> 2) & 7, qb = u & 3; const size_t r0 = (size_t)b * SEQ, rq = r0 + qb * 512;
                const size_t hb = ((size_t)(b * 8 + hd) * SEQ) * 128;
                attn_dense_unit<96, 64, 64, 2>((LAS char*)lds, QB + rq * 768 + hd * 96, 768, KVB + hb, 128, KRB + r0 * 32, 32,
                                            KVB + hb + 64, 128, SEQ, PROJ + rq * NP + C_BG + hd * 64, NP, SSQY + rq * 32 + 16 + hd);
            } } else if (u < U_B + U_A) { if (ATT_MASK & 2) {
                APf pf;
                auto mk_head = [&](int v_) -> AHead { const int b_ = v_ / 64, hd_ = (v_ >> 2) & 15; const size_t hb = ((size_t)(b_ * 16 + hd_) * SEQ) * 64, tq = (size_t)T * 1024;
                    return AHead{QHB + hb, QHB + tq + hb, QHB + 2 * tq + hb, PROJ + (size_t)b_ * SEQ * NP + C_AG + hd_ * 64}; };
                { const int v = u - U_B; const AHead h0 = mk_head(v); a_first_issue<16>(pf, h0, (v & 3) * 512, wave, lane); }
                for (;;) {
                    const int ucur = unit_of(it);
                    const int v = ucur - U_B, b = v / 64, hd = (v >> 2) & 15, blk = v & 3; const int P0 = blk * 512;
                    const AHead hp = mk_head(v);
                    float* ssqa = SSQY + (size_t)b * SEQ * 32 + hd;
                    const int w1 = wave + 8;
                    attnA_pass<16, 0>((LAS char*)lds, hp, ssqa, P0, wave, lane, pf, [&]() { a_first_issue<16>(pf, hp, P0, w1, lane); });
                    attnA_pass<16, 0>((LAS char*)lds, hp, ssqa, P0, w1, lane, pf, [&]() { a_first_issue<4>(pf, hp, P0, wave, lane); }); __syncthreads();
                    attnA_pass<4, 1>((LAS char*)lds, hp, ssqa, P0, wave, lane, pf, [&]() { a_first_issue<4>(pf, hp, P0, w1, lane); });
                    attnA_pass<4, 1>((LAS char*)lds, hp, ssqa, P0, w1, lane, pf, [&]() { a_first_issue<1>(pf, hp, P0, wave, lane); }); __syncthreads();
                    const int u2 = unit_of(it + 1); const bool nextA = (u2 >= U_B && u2 < U_B + U_A);
                    const int v2 = nextA ? u2 - U_B : v; const AHead hp2 = mk_head(v2); const int P02 = (v2 & 3) * 512;
                    attnA_pass<1, 2>((LAS char*)lds, hp, ssqa, P0, wave, lane, pf, [&]() { a_first_issue<1>(pf, hp, P0, w1, lane); });
                    attnA_pass<1, 2>((LAS char*)lds, hp, ssqa, P0, w1, lane, pf, [&]() { if (nextA) a_first_issue<16>(pf, hp2, P02, wave, lane); });
                    __syncthreads();
                    if (!nextA) break;
                    ++it;
                }
            } } else { if (ATT_MASK & 4) {
                const int v = u - U_B - U_A, b = v / 32, hd = (v >> 3) & 3, qb = v & 7; const size_t rq = (size_t)b * SEQ + qb * 256, rm = (size_t)b * NMEM;
                attn_dense_unit<128, 128, 128, 1>((LAS char*)lds, PROJ + rq * NP + C_MQ + hd * 128, NP, MKV + rm * 1024 + hd * 128, 1024, MKV, 1024,
                                               MKV + rm * 1024 + 512 + hd * 128, 1024, NMEM, PROJ + rq * NP + C_MG + hd * 128, NP, SSQY + rq * 32 + 24 + hd);
            } }
        }
    }
    SEAM(3);

    if (IN(4)) for (int rep = 0; rep < REPS(4); ++rep) { if (rep) grid.sync();
        pg8::Gemm g{PROJ + C_AG, WOUT, NP, 2048, 2048}; pg8::StaticOrder S; S.init(T, DM, G, bx);
        LAS f32x4* rtab = (LAS f32x4*)(lds + pg8::STAGE_BYTES);
        for (int i = 0; i < 2; ++i) { Unit u;
            if (S.next(i, u) && tid < 256) {
                const float* sp = SSQY + ((size_t)u.pm * 256 + tid) * 32;
                float sa = 0.f, sb = 0.f, sm = 0.f;
#pragma unroll
                for (int j = 0; j < 4; ++j) { const f32x4 t4 = *(const f32x4*)(sp + 4 * j); sa += (t4[0] + t4[1]) + (t4[2] + t4[3]); }
#pragma unroll
                for (int j = 4; j < 6; ++j) { const f32x4 t4 = *(const f32x4*)(sp + 4 * j); sb += (t4[0] + t4[1]) + (t4[2] + t4[3]); }
                { const f32x4 t4 = *(const f32x4*)(sp + 24); sm = (t4[0] + t4[1]) + (t4[2] + t4[3]); }
                const float ra = __builtin_amdgcn_rsqf(sa * (1.0f / 1024.0f) + EPS), rb = __builtin_amdgcn_rsqf(sb * (1.0f / 512.0f) + EPS), rm = __builtin_amdgcn_rsqf(sm * (1.0f / 512.0f) + EPS);
                rtab[i * 256 + tid] = (f32x4){ra / rb, rb / rm, rm, 0.f};
            } }
        __syncthreads();
        EpiOut E{QHB, H, PSTAT, rtab};
        pg8::gemm_phase<EpiOut, true>(lds, g, S, E);
    }
    SEAM(4);

    if (IN(5)) {
        f32x4 gg[4], bb[4];
#pragma unroll
        for (int j = 0; j < 4; ++j) { gg[j] = *((const f32x4*)a.g_post + lane + 64 * j); bb[j] = *((const f32x4*)a.b_post + lane + 64 * j); }
        u32x2 npk[4]; f32x2 np = {0.f, 0.f};
        if (gw < T) {
            if (lane < 16) np = *(const f32x2*)(PSTAT + ((size_t)gw * 16 + lane) * 2);
#pragma unroll
            for (int j = 0; j < 4; ++j) npk[j] = *((const u32x2*)(QHB + (size_t)gw * DM) + lane + 64 * j);
        }
        for (int m = gw; m < T; m += NGW) {
            float s = np[0], q = np[1];
            u32x2 pk[4];
#pragma unroll
            for (int j = 0; j < 4; ++j) pk[j] = npk[j];
            if (m + NGW < T) {
                np = (f32x2){0.f, 0.f};
                if (lane < 16) np = *(const f32x2*)(PSTAT + ((size_t)(m + NGW) * 16 + lane) * 2);
#pragma unroll
                for (int j = 0; j < 4; ++j) npk[j] = *((const u32x2*)(QHB + (size_t)(m + NGW) * DM) + lane + 64 * j);
            }
            s = wave_sum(s); q = wave_sum(q);
            const float mean = s * (1.f / DM), var = fmaxf(q * (1.f / DM) - mean * mean, 0.f), rstd = 1.0f / sqrtf(var + EPS);
            f32x4* orow = (f32x4*)(a.out + (size_t)m * DM) + lane;
#pragma unroll
            for (int j = 0; j < 4; ++j) {
                const f32x4 v = {__builtin_bit_cast(float, pk[j].x << 16), __builtin_bit_cast(float, pk[j].x & 0xffff0000u), __builtin_bit_cast(float, pk[j].y << 16), __builtin_bit_cast(float, pk[j].y & 0xffff0000u)};
                orow[64 * j] = (v - mean) * rstd * gg[j] + bb[j];
            }
        }
    }
#undef IN
#undef SEAM
}

extern "C" void kernel_launch(void* const* d_in, const int* in_sizes, int n_in, void* d_out, int out_size, void* d_ws, size_t ws_size, hipStream_t stream) {
    static int grid_blocks = 0;
    if (grid_blocks == 0) {
        int dev = 0, cus = 0, per_cu = 0;
        hipGetDevice(&dev);
        hipDeviceGetAttribute(&cus, hipDeviceAttributeMultiprocessorCount, dev);
        hipFuncSetAttribute((const void*)fwd_mega, hipFuncAttributeMaxDynamicSharedMemorySize, LDS_BYTES);
        hipOccupancyMaxActiveBlocksPerMultiprocessor(&per_cu, (const void*)fwd_mega, NTHREADS, LDS_BYTES);
        if (per_cu < 1) { fprintf(stderr, "kernel_launch: occupancy query reports %d blocks/CU\n", per_cu); per_cu = 1; }
        if (per_cu > 1) per_cu = 1;
        grid_blocks = cus * per_cu;
        if (ws_size < WS_END) { fprintf(stderr, "kernel_launch: workspace too small (%zu < %zu)\n", ws_size, (size_t)WS_END); }
    }
    (void)hipMemsetAsync((unsigned char*)d_ws + WS_BAR, 0, XCD_BAR_WORDS * 4, stream);
    Args a{};
    a.x = (const float*)d_in[0]; a.mem = (const float*)d_in[1]; a.pos = (const int*)d_in[2]; a.g_emb = (const float*)d_in[3]; a.b_emb = (const float*)d_in[4];
    a.w_in = (const float*)d_in[5]; a.g_cq = (const float*)d_in[6]; a.g_ckv = (const float*)d_in[7]; a.w_uq = (const float*)d_in[8]; a.w_ukv = (const float*)d_in[9];
    a.w_mem_kv = (const float*)d_in[10]; a.g_out_a = (const float*)d_in[11]; a.g_out_b = (const float*)d_in[12]; a.g_out_m = (const float*)d_in[13]; a.w_out = (const float*)d_in[14];
    a.g_post = (const float*)d_in[15]; a.b_post = (const float*)d_in[16]; a.out = (float*)d_out; a.ws = (unsigned char*)d_ws; a.ph_lo = 0; a.ph_hi = 6;
    void* args[] = {&a};
    hipError_t e = hipLaunchCooperativeKernel((const void*)fwd_mega, dim3(grid_blocks), dim3(NTHREADS), args, LDS_BYTES, stream);
    if (e != hipSuccess) fprintf(stderr, "cooperative launch failed: %s (grid %d)\n", hipGetErrorString(e), grid_blocks);
}
```
